# Optimizing an MI355X kernel written in HIP

```python
import math
import jax, jax.numpy as jnp
from jax import lax
import numpy as np

D_MODEL = 1024
BATCH = 2
SEQ = 8192
DEPTH = 1
DEC_BATCH = 32
DEC_SEQ = 32
PAST_LEN = 2048

CHUNK = 64
Q_BLOCK = 128
EPS = 1e-6

DA_HEADS = 4
DA_DK = 64
DA_DV = 2 * DA_DK
DA_QK = DA_HEADS * 2 * DA_DK
DA_WIDTH = DA_HEADS * DA_DV

GLA_HEADS = 4
GLA_DK = 64
GLA_DV = 128
GLA_KW = GLA_HEADS * GLA_DK
GLA_VW = GLA_HEADS * GLA_DV
GLA_GATE_RANK = 16
GLA_TAU = 16.0

IN_SIZES = (DA_QK, DA_QK, DA_WIDTH, DA_WIDTH, GLA_KW, GLA_KW, GLA_VW, GLA_VW, GLA_GATE_RANK, 2 * D_MODEL)
D_IN = sum(IN_SIZES)

kernel_name = "hybrid_diffattn_gla_streaming_step"


def rmsnorm(x, g):
    xf = x.astype(jnp.float32)
    y = xf * lax.rsqrt(jnp.mean(xf * xf, axis=-1, keepdims=True) + EPS)
    return (y * g.astype(jnp.float32)).astype(x.dtype)


def project(x, g_in, w_in, w_alpha_up, b_alpha):
    bsz, t, _ = x.shape
    xn = rmsnorm(x, g_in)
    h = xn @ w_in
    split_points = [int(o) for o in np.cumsum(IN_SIZES)[:-1]]
    dq, dk, dv, dg, gq, gk, gv, gg, ga, mg = jnp.split(h, split_points, axis=-1)
    dq = dq.reshape(bsz, t, DA_HEADS, 2, DA_DK)
    dk = dk.reshape(bsz, t, DA_HEADS, 2, DA_DK)
    dv = dv.reshape(bsz, t, DA_HEADS, DA_DV)
    gq = gq.reshape(bsz, t, GLA_HEADS, GLA_DK) * (GLA_DK ** -0.5)
    gk = gk.reshape(bsz, t, GLA_HEADS, GLA_DK)
    gv = gv.reshape(bsz, t, GLA_HEADS, GLA_DV)
    log_a = jax.nn.log_sigmoid((ga @ w_alpha_up + b_alpha).astype(jnp.float32)) / GLA_TAU
    log_a = log_a.reshape(bsz, t, GLA_HEADS, GLA_DK)
    return dq, dk, dv, dg, gq, gk, gv, gg, log_a, mg


def diff_lambda(lq1, lk1, lq2, lk2, lam_init):
    f32 = jnp.float32
    return (jnp.exp(jnp.sum(lq1.astype(f32) * lk1.astype(f32)))
            - jnp.exp(jnp.sum(lq2.astype(f32) * lk2.astype(f32))) + lam_init)


def diff_attend(q, k, v, lam, mask):
    s = jnp.einsum('bqhmd,bkhmd->bhmqk', q, k).astype(jnp.float32) * (DA_DK ** -0.5)
    if mask is not None:
        s = jnp.where(mask, s, -jnp.inf)
    p = jax.nn.softmax(s, axis=-1)
    a = p[:, :, 0] - lam * p[:, :, 1]
    return jnp.einsum('bhqk,bkhv->bqhv', a.astype(v.dtype), v)


def diff_attend_prompt(q, k, v, lam):
    bsz, t = q.shape[0], q.shape[1]
    nqb = t // Q_BLOCK
    qb = jnp.moveaxis(q.reshape(bsz, nqb, Q_BLOCK, DA_HEADS, 2, DA_DK), 1, 0)
    key_chunk = jnp.arange(t) // CHUNK

    def one_block(args):
        qblk, i = args
        q_chunk = (i * Q_BLOCK + jnp.arange(Q_BLOCK)) // CHUNK
        mask = key_chunk[None, :] <= q_chunk[:, None]
        return diff_attend(qblk, k, v, lam, mask)

    o = lax.map(one_block, (qb, jnp.arange(nqb)))
    return jnp.moveaxis(o, 0, 1).reshape(bsz, t, DA_HEADS, DA_DV)


def gla_chunk(S, q, k, v, log_a):
    f32 = jnp.float32
    qf, kf, vf = q.astype(f32), k.astype(f32), v.astype(f32)
    c = q.shape[1]
    b = jnp.cumsum(log_a, axis=1)
    causal = jnp.tril(jnp.ones((c, c), dtype=bool))
    rel = b[:, :, None] - b[:, None, :]
    decay = jnp.exp(jnp.where(causal[None, :, :, None, None], rel, -jnp.inf))
    att = jnp.einsum('bthk,bshk,btshk->bhts', qf, kf, decay)
    o = (jnp.einsum('bhts,bshv->bthv', att, vf)
         + jnp.einsum('bthk,bhkv->bthv', qf * jnp.exp(b), S))
    b_last = b[:, -1]
    k_dec = kf * jnp.exp(b_last[:, None] - b)
    S_new = jnp.exp(b_last)[..., None] * S + jnp.einsum('bshk,bshv->bhkv', k_dec, vf)
    return S_new, o


def gla_prompt(q, k, v, log_a):
    bsz, t = q.shape[0], q.shape[1]
    n = t // CHUNK

    def to_chunks(a):
        return jnp.moveaxis(a.reshape(bsz, n, CHUNK, *a.shape[2:]), 1, 0)

    S0 = jnp.zeros((bsz, GLA_HEADS, GLA_DK, GLA_DV), jnp.float32)
    S_fin, o = lax.scan(lambda S, xs: gla_chunk(S, *xs), S0,
                        (to_chunks(q), to_chunks(k), to_chunks(v), to_chunks(log_a)))
    return S_fin, jnp.moveaxis(o, 0, 1).reshape(bsz, t, GLA_HEADS, GLA_DV)


def merge_branches(x, oa, ob, da_gate, gla_gate, merge_logits, da_norm_g, gla_norm_g,
                   lam_init, w_branch_a, w_branch_b, w_out):
    bsz, t, _ = x.shape
    oa = rmsnorm(oa.astype(x.dtype), da_norm_g) * (1.0 - lam_init)
    oa = oa.reshape(bsz, t, DA_WIDTH) * jax.nn.silu(da_gate)
    ob = rmsnorm(ob.astype(x.dtype), gla_norm_g).reshape(bsz, t, GLA_VW) * jax.nn.silu(gla_gate)
    g_a, g_b = jnp.split(jax.nn.sigmoid(merge_logits), 2, axis=-1)
    mixed = g_a * (oa @ w_branch_a) + g_b * (ob @ w_branch_b)
    return x + mixed @ w_out


def setup_inputs(seed: int = 0) -> dict:
    key = jax.random.key(seed)
    ks = jax.random.split(key, 20)
    f32 = jnp.float32
    nrm = lambda k, shape, s: (jax.random.normal(k, shape, f32) * s)
    return {
        "x_prompt": nrm(ks[0], (BATCH, SEQ, D_MODEL), 1.0),
        "x_sample": nrm(ks[1], (DEC_BATCH, DEC_SEQ, D_MODEL), 1.0),
        "cache_k": nrm(ks[2], (DEPTH, DEC_BATCH, PAST_LEN, DA_HEADS, 2, DA_DK), 1.0),
        "cache_v": nrm(ks[3], (DEPTH, DEC_BATCH, PAST_LEN, DA_HEADS, DA_DV), 1.0),
        "state_gla": nrm(ks[4], (DEPTH, DEC_BATCH, GLA_HEADS, GLA_DK, GLA_DV), 1.0),
        "norm_in_g": 1.0 + nrm(ks[5], (DEPTH, D_MODEL), 0.02),
        "w_in": nrm(ks[6], (DEPTH, D_MODEL, D_IN), D_MODEL ** -0.5),
        "w_alpha_up": nrm(ks[7], (DEPTH, GLA_GATE_RANK, GLA_KW), GLA_GATE_RANK ** -0.5),
        "b_alpha": nrm(ks[8], (DEPTH, GLA_KW), 0.1),
        "lambda_q1": nrm(ks[9], (DEPTH, DA_DK), 0.1),
        "lambda_k1": nrm(ks[10], (DEPTH, DA_DK), 0.1),
        "lambda_q2": nrm(ks[11], (DEPTH, DA_DK), 0.1),
        "lambda_k2": nrm(ks[12], (DEPTH, DA_DK), 0.1),
        "da_norm_g": 1.0 + nrm(ks[13], (DEPTH, DA_DV), 0.02),
        "gla_norm_g": 1.0 + nrm(ks[14], (DEPTH, GLA_DV), 0.02),
        "w_branch_a": nrm(ks[15], (DEPTH, DA_WIDTH, D_MODEL), DA_WIDTH ** -0.5),
        "w_branch_b": nrm(ks[16], (DEPTH, GLA_VW, D_MODEL), GLA_VW ** -0.5),
        "w_out": nrm(ks[17], (DEPTH, D_MODEL, D_MODEL), D_MODEL ** -0.5),
        "norm_final_g": 1.0 + nrm(ks[18], (D_MODEL,), 0.02),
    }


def reference(x_prompt, x_sample, cache_k, cache_v, state_gla, norm_in_g, w_in, w_alpha_up, b_alpha,
              lambda_q1, lambda_k1, lambda_q2, lambda_k2, da_norm_g, gla_norm_g,
              w_branch_a, w_branch_b, w_out, norm_final_g):
    xp, xs = x_prompt, x_sample
    kp_all, vp_all, sp_all, ks_all, vs_all, ss_all = [], [], [], [], [], []
    for l in range(DEPTH):
        lam_init = 0.8 - 0.6 * math.exp(-0.3 * l)
        lam = diff_lambda(lambda_q1[l], lambda_k1[l], lambda_q2[l], lambda_k2[l], lam_init)

        dq, dk, dv, dg, gq, gk, gv, gg, log_a, mg = project(xp, norm_in_g[l], w_in[l], w_alpha_up[l], b_alpha[l])
        oa = diff_attend_prompt(dq, dk, dv, lam)
        s_p, ob = gla_prompt(gq, gk, gv, log_a)
        xp = merge_branches(xp, oa, ob, dg, gg, mg, da_norm_g[l], gla_norm_g[l], lam_init,
                            w_branch_a[l], w_branch_b[l], w_out[l])
        kp_all.append(dk)
        vp_all.append(dv)
        sp_all.append(s_p.astype(x_prompt.dtype))

        dq, dk, dv, dg, gq, gk, gv, gg, log_a, mg = project(xs, norm_in_g[l], w_in[l], w_alpha_up[l], b_alpha[l])
        k_full = jnp.concatenate([cache_k[l], dk], axis=1)
        v_full = jnp.concatenate([cache_v[l], dv], axis=1)
        oa = diff_attend(dq, k_full, v_full, lam, None)
        s_s, ob = gla_chunk(state_gla[l].astype(jnp.float32), gq, gk, gv, log_a)
        xs = merge_branches(xs, oa, ob, dg, gg, mg, da_norm_g[l], gla_norm_g[l], lam_init,
                            w_branch_a[l], w_branch_b[l], w_out[l])
        ks_all.append(dk)
        vs_all.append(dv)
        ss_all.append(s_s.astype(state_gla.dtype))

    y_prompt = rmsnorm(xp, norm_final_g)
    y_sample = rmsnorm(xs, norm_final_g)
    new_k_prompt = jnp.stack(kp_all)
    new_v_prompt = jnp.stack(vp_all)
    new_gla_prompt = jnp.stack(sp_all)
    new_k_sample = jnp.stack(ks_all)
    new_v_sample = jnp.stack(vs_all)
    new_gla_sample = jnp.stack(ss_all)
    return (y_prompt, y_sample, new_k_prompt, new_v_prompt, new_gla_prompt, new_k_sample, new_v_sample, new_gla_sample)
```

```cpp
#include <hip/hip_runtime.h>
#include <cstdio>
#include <cstdint>

typedef unsigned short ushort_t;
typedef short bf16x8 __attribute__((ext_vector_type(8)));
typedef float f32x2 __attribute__((ext_vector_type(2)));
typedef float f32x4 __attribute__((ext_vector_type(4)));
typedef float f32x16 __attribute__((ext_vector_type(16)));
typedef unsigned u32x4 __attribute__((ext_vector_type(4)));
typedef unsigned u32x2 __attribute__((ext_vector_type(2)));
typedef __bf16 bf16x2_t __attribute__((ext_vector_type(2)));

#define NT 512
#define TP 16384
#define TS 1024
#define TT 17408
#define DM 1024
#define NPAD 5888
#define EPS 1e-6f
#define QSCALE (0.125f * 1.4426950408889634f)

#define O_YP 0
#define O_YS 16777216
#define O_KP 17825792
#define O_VP 26214400
#define O_GP 34603008
#define O_KS 34668544
#define O_VS 35192832
#define O_GS 35717120

#define WS_CTRL   0ull
#define WS_WTIN   (65536ull)
#define WS_WAT    (WS_WTIN + (size_t)NPAD * 1024 * 2)
#define WS_WBT    (WS_WAT + 1024ull * 512 * 2)
#define WS_WOT    (WS_WBT + 1024ull * 512 * 2)
#define WS_XN     (WS_WOT + 1024ull * 1024 * 2)
#define WS_QA     (WS_XN + (size_t)TT * 1024 * 2)
#define WS_KA     (WS_QA + (size_t)TT * 512 * 2)
#define WS_VTP    (WS_KA + (size_t)TT * 512 * 2)
#define WS_VTS    (WS_VTP + (size_t)TP * 512 * 2)
#define WS_DGS    (WS_VTS + (size_t)TS * 512 * 2)
#define WS_GQK    (WS_DGS + (size_t)TT * 512 * 2)
#define WS_GVTP   (WS_GQK + (size_t)TT * 512 * 2)
#define WS_GVTS   (WS_GVTP + (size_t)TP * 512 * 2)
#define WS_GGS    (WS_GVTS + (size_t)TS * 512 * 2)
#define WS_GAF    (WS_GGS + (size_t)TT * 512 * 2)
#define WS_MGS    (WS_GAF + (size_t)TT * 16 * 4)
#define WS_OAF    (WS_MGS + (size_t)TT * 2048 * 2)
#define WS_OBF    (WS_OAF + (size_t)TT * 512 * 2)
#define WS_GLAT   (WS_OBF + (size_t)TT * 512 * 2)
#define WS_GLAD   (WS_GLAT + 1024ull * 8192 * 4)
#define WS_GLAS   (WS_GLAD + 1024ull * 64 * 4)
#define WS_MIX    (WS_GLAS + 1024ull * 8192 * 2)
#define WS_SSQ    (WS_MIX + (size_t)TT * 1024 * 2)
#define WS_BCUM   (WS_SSQ + (size_t)TT * 16 * 4)
#define WS_END    (WS_BCUM + (size_t)TP * 256 * 4)

struct Params {
  const float *x_prompt, *x_sample, *cache_k, *cache_v, *state_gla, *norm_in_g, *w_in, *w_alpha_up, *b_alpha;
  const float *lq1, *lk1, *lq2, *lk2, *da_norm_g, *gla_norm_g, *w_branch_a, *w_branch_b, *w_out, *norm_final_g;
  float* out;
  char* ws;
  int phase_lo, phase_hi;
};

#ifndef PHASE_MASK
#define PHASE_MASK 0xFF
#endif
#define PH_ON(n) ((PHASE_MASK >> (n)) & 1)
#ifndef P2SUB
#define P2SUB 15
#endif
#ifndef REPEAT_MASK
#define REPEAT_MASK 0
#endif
#define REP_ON(n) ((REPEAT_MASK >> (n)) & 1)
#ifndef MK_ONE_LAUNCH
#define MK_ONE_LAUNCH 1
#endif

__device__ __forceinline__ unsigned pack2(float a, float b) {
  f32x2 v = {a, b};
  bf16x2_t r = __builtin_convertvector(v, bf16x2_t);
  return *(unsigned*)&r;
}
__device__ __forceinline__ ushort_t f2bf(float f) { return (ushort_t)(pack2(f, 0.f) & 0xffffu); }
__device__ __forceinline__ f32x4 mkf4(float a, float b, float c, float d) { f32x4 r = {a, b, c, d}; return r; }
__device__ __forceinline__ float bf2f(ushort_t h) { return __uint_as_float(((unsigned)h) << 16); }
__device__ __forceinline__ float bflo(unsigned u) { return __uint_as_float(u << 16); }
__device__ __forceinline__ float bfhi(unsigned u) { return __uint_as_float(u & 0xffff0000u); }
__device__ __forceinline__ u32x2 pack4(float a, float b, float c, float d) {
  u32x2 r; r.x = pack2(a, b); r.y = pack2(c, d); return r;
}
__device__ __forceinline__ float wave_sum(float v) {
#pragma unroll
  for (int o = 32; o >= 1; o >>= 1) v += __shfl_xor(v, o);
  return v;
}
__device__ __forceinline__ float silu_f(float x) { return x * __builtin_amdgcn_rcpf(1.f + __expf(-x)); }
__device__ __forceinline__ float sigmoid_f(float x) { return 1.f / (1.f + __expf(-x)); }

__device__ __forceinline__ int ltid() { int t = threadIdx.x; asm volatile("" : "+v"(t)); return t; }
__device__ __forceinline__ float xmax32(float x) {
  const unsigned xi = __float_as_uint(x);
  auto r = __builtin_amdgcn_permlane32_swap(xi, xi, false, false);
  return fmaxf(__uint_as_float(r[0]), __uint_as_float(r[1]));
}
__device__ __forceinline__ u32x4 widen16(u32x2 p0, u32x2 p1) {
  auto a = __builtin_amdgcn_permlane16_swap(p0.x, p1.x, false, false);
  auto b = __builtin_amdgcn_permlane16_swap(p0.y, p1.y, false, false);
  return (u32x4){a[0], b[0], a[1], b[1]};
}
#define MFMA32(a, b, c) __builtin_amdgcn_mfma_f32_32x32x16_bf16((a), (b), (c), 0, 0, 0)

#define XB_TMO      128
#define XB_XCNT(j)  (256  + 64 * (j))
#define XB_XSUB(j)  (1280 + 64 * (j))
#define XB_XGEN(j)  (2304 + 64 * (j))
#define XB_TOP      3328
#define XB_TOPGEN   3392
#define XCD_BAR_WORDS 3456
#define XB_SPIN_CAP (1u << 22)
#define LAS __attribute__((address_space(3)))

__device__ __forceinline__ unsigned xb_ld(unsigned* p) { return __hip_atomic_load(p, __ATOMIC_RELAXED, __HIP_MEMORY_SCOPE_AGENT); }
__device__ __forceinline__ unsigned xb_add(unsigned* p, unsigned v) { return __hip_atomic_fetch_add(p, v, __ATOMIC_RELAXED, __HIP_MEMORY_SCOPE_AGENT); }
__device__ __forceinline__ unsigned xb_xcc_id() { return (unsigned)__builtin_amdgcn_s_getreg((3 << 11) | 20) & 0xFu; }
#define XB_SPIN(cond, bar) do { unsigned _sp = 0; while (cond) { __builtin_amdgcn_s_sleep(6);   \
    if ((++_sp & 255u) == 0u) { if (xb_ld(&(bar)[XB_TMO])) break; if (_sp > XB_SPIN_CAP) { atomicAdd(&(bar)[XB_TMO], 1u); break; } } } } while (0)

struct XcdBarrier { unsigned* bar; unsigned x; volatile unsigned* st; };

__device__ __forceinline__ XcdBarrier xcd_barrier_post(unsigned* bar, volatile unsigned* st) {
  XcdBarrier b; b.bar = bar; b.x = xb_xcc_id(); b.st = st;
  if (threadIdx.x == 0) (void)xb_add(&bar[XB_XCNT(b.x)], 1u);
  return b;
}
__device__ __forceinline__ void xcd_barrier_complete(unsigned* bar, unsigned x, unsigned& nloc, unsigned& nx) {
  const unsigned G = gridDim.x * gridDim.y * gridDim.z;
  unsigned sum, cnt, mine, sp = 0u;
  for (;;) {
    sum = 0u; cnt = 0u; mine = 0u;
#pragma unroll
    for (unsigned j = 0; j < 16; ++j) { const unsigned c = xb_ld(&bar[XB_XCNT(j)]); sum += c; cnt += (c > 0u) ? 1u : 0u; mine = (j == x) ? c : mine; }
    if (sum == G) break;
    __builtin_amdgcn_s_sleep(1);
    if ((++sp & 255u) == 0u) { if (xb_ld(&bar[XB_TMO])) break; if (sp > XB_SPIN_CAP) { atomicAdd(&bar[XB_TMO], 1u); break; } }
  }
  nloc = mine > 0u ? mine : 1u; nx = cnt > 0u ? cnt : 1u;
}
__device__ __forceinline__ void xcd_barrier(const XcdBarrier& b) {
  asm volatile("s_waitcnt vmcnt(0)" ::: "memory");
  __syncthreads();
  if (threadIdx.x == 0) {
    unsigned* bar = b.bar;
    __builtin_amdgcn_s_waitcnt(0);
    unsigned nloc = b.st[0], nx = b.st[1];
    if (nloc == 0u) { xcd_barrier_complete(bar, b.x, nloc, nx); b.st[0] = nloc; b.st[1] = nx; }
    const unsigned old = xb_add(&bar[XB_XSUB(b.x)], 1u);
    const unsigned gen = old / nloc;
    if (old + 1u == (gen + 1u) * nloc) {
      __builtin_amdgcn_fence(__ATOMIC_RELEASE, "agent");
      asm volatile("s_waitcnt vmcnt(0)" ::: "memory");
      const unsigned og = xb_add(&bar[XB_TOP], 1u);
      const unsigned tg = og / nx;
      if (og + 1u == (tg + 1u) * nx) xb_add(&bar[XB_TOPGEN], 1u);
      else XB_SPIN(xb_ld(&bar[XB_TOPGEN]) == tg, bar);
      __builtin_amdgcn_fence(__ATOMIC_ACQUIRE, "agent");
      xb_add(&bar[XB_XGEN(b.x)], 1u);
      asm volatile("s_waitcnt vmcnt(0)" ::: "memory");
    } else {
      XB_SPIN(xb_ld(&bar[XB_XGEN(b.x)]) == gen, bar);
      __builtin_amdgcn_fence(__ATOMIC_ACQUIRE, "agent");
      asm volatile("s_waitcnt vmcnt(0)" ::: "memory");
    }
  }
  __syncthreads();
}

__device__ __forceinline__ int perm_in(int n) {
  if (n < 3584) return n;
  if (n < 3600) return 5632 + (n - 3584);
  const int c = n - 3600, isB = c >> 10, cc = c & 1023;
  return 3584 + (cc >> 7) * 256 + isB * 128 + (cc & 127);
}

__device__ __forceinline__ void p0_transpose_block(const float* __restrict__ src, int K, int N, int k0, int n0,
                                                   ushort_t* __restrict__ dst, bool permute, float* sT) {
  const int tid = ltid();
  const int c = tid & 255, r0 = tid >> 8;
  float v[32];
  const bool ok = (n0 + c) < N;
#pragma unroll
  for (int i = 0; i < 32; ++i) v[i] = ok ? __builtin_nontemporal_load(&src[(size_t)(k0 + r0 + 2 * i) * N + n0 + c]) : 0.f;
#pragma unroll
  for (int i = 0; i < 32; ++i) sT[(r0 + 2 * i) * 257 + c] = v[i];
  __syncthreads();
  const int kk = tid & 63, nn0 = tid >> 6;
#pragma unroll 8
  for (int i = 0; i < 32; ++i) {
    const int nn = nn0 + 8 * i, n = n0 + nn;
    if (n < N) {
      const int nd = permute ? perm_in(n) : n;
      dst[(size_t)nd * K + k0 + kk] = f2bf(sT[kk * 257 + nn]);
    }
  }
  __syncthreads();
}

__device__ __forceinline__ void phase0(const Params& p, float* smem) {
  const int tid = ltid();
  ushort_t* wtin = (ushort_t*)(p.ws + WS_WTIN);
  ushort_t* wat = (ushort_t*)(p.ws + WS_WAT);
  ushort_t* wbt = (ushort_t*)(p.ws + WS_WBT);
  ushort_t* wot = (ushort_t*)(p.ws + WS_WOT);
  ushort_t* xn = (ushort_t*)(p.ws + WS_XN);
  {
    const int wave = tid >> 6, lane = tid & 63;
    const int ngrp = TT / 4;
    for (int g = blockIdx.x * 8 + wave; g < ngrp; g += gridDim.x * 8) {
      const int row = g * 4;
      const float* xr = (row < TP) ? (p.x_prompt + (size_t)row * DM) : (p.x_sample + (size_t)(row - TP) * DM);
      f32x4 v[4][4];
#pragma unroll
      for (int rr = 0; rr < 4; ++rr)
#pragma unroll
        for (int i = 0; i < 4; ++i) v[rr][i] = __builtin_nontemporal_load(&((const f32x4*)(xr + (size_t)rr * DM))[lane + 64 * i]);
      float rn[4];
#pragma unroll
      for (int rr = 0; rr < 4; ++rr) {
        float ss = 0.f;
#pragma unroll
        for (int i = 0; i < 4; ++i) ss += v[rr][i].x * v[rr][i].x + v[rr][i].y * v[rr][i].y + v[rr][i].z * v[rr][i].z + v[rr][i].w * v[rr][i].w;
        ss = wave_sum(ss);
        rn[rr] = rsqrtf(ss * (1.f / DM) + EPS);
      }
#pragma unroll
      for (int i = 0; i < 4; ++i) {
        const f32x4 g4 = ((const f32x4*)p.norm_in_g)[lane + 64 * i];
#pragma unroll
        for (int rr = 0; rr < 4; ++rr)
          ((u32x2*)(xn + (size_t)(row + rr) * DM))[lane + 64 * i] =
              pack4(v[rr][i].x * rn[rr] * g4.x, v[rr][i].y * rn[rr] * g4.y, v[rr][i].z * rn[rr] * g4.z, v[rr][i].w * rn[rr] * g4.w);
      }
    }
  }
  const int n_in = 16 * 23, n_a = 32, n_b = 32, n_o = 64;
  const int n_tr = n_in + n_a + n_b + n_o;
  for (int it = blockIdx.x; it < n_tr; it += gridDim.x) {
    if (it < n_in) {
      int kt = it / 23, nt = it % 23;
      p0_transpose_block(p.w_in, 1024, 5648, kt * 64, nt * 256, wtin, true, smem);
    } else if (it < n_in + n_a) {
      int j = it - n_in; int kt = j / 4, nt = j % 4;
      p0_transpose_block(p.w_branch_a, 512, 1024, kt * 64, nt * 256, wat, false, smem);
    } else if (it < n_in + n_a + n_b) {
      int j = it - n_in - n_a; int kt = j / 4, nt = j % 4;
      p0_transpose_block(p.w_branch_b, 512, 1024, kt * 64, nt * 256, wbt, false, smem);
    } else {
      int j = it - n_in - n_a - n_b; int kt = j / 4, nt = j % 4;
      p0_transpose_block(p.w_out, 1024, 1024, kt * 64, nt * 256, wot, false, smem);
    }
  }
}

#define G_BK 64
#define G_HALF 128
#define G_HT (G_HALF * G_BK)

__device__ __forceinline__ int lds_byte(int r, int c) {
  int st = (r >> 4) * 2 + (c >> 5), rr = r & 15, cc = c & 31, ob = rr * 64 + cc * 2;
  return st * 1024 + (ob ^ (((ob >> 9) & 1) << 5));
}
__device__ __forceinline__ void stage_rc(int b, int& R, int& C) {
  int st = b / 1024, sb = b % 1024, swz = sb ^ (((sb >> 9) & 1) << 5);
  R = (st >> 1) * 16 + swz / 64; C = (st & 1) * 32 + (swz % 64) / 2;
}

#define SA(b, h) (shm + ((b) * 2 + (h)) * G_HT)
#define SB(b, h) (shm + (4 + (b) * 2 + (h)) * G_HT)
#define STAGE(P, BASE, br, kt) do { const char* _ub = (const char*)((BASE) + (long)(br) * K + (long)(kt) * G_BK); \
    _Pragma("unroll") for (int _i = 0; _i < 2; ++_i) { \
      __builtin_amdgcn_global_load_lds((const unsigned*)(_ub + (size_t)so_b[_i]), \
        (LAS unsigned*)((LAS char*)(P) + tl * 16 + _i * 8192), 16, 0, 0); } } while (0)
#define LDA(dst, b, h) for (int m = 0; m < 4; ++m) for (int k = 0; k < 2; ++k) \
    dst[m][k] = *reinterpret_cast<const LAS bf16x8*>((const LAS char*)SA(b, h) + lds_byte(wr * 64 + m * 16 + fr, k * 32 + fq * 8))
#define LDB(dst, b, h) for (int n = 0; n < 2; ++n) for (int k = 0; k < 2; ++k) \
    dst[n][k] = *reinterpret_cast<const LAS bf16x8*>((const LAS char*)SB(b, h) + lds_byte(wc * 32 + n * 16 + fr, k * 32 + fq * 8))
#define MMA(ai, bj, At, Bt_) do { __builtin_amdgcn_s_setprio(1); \
    for (int m = 0; m < 4; ++m) for (int n = 0; n < 2; ++n) for (int k = 0; k < 2; ++k) \
      acc[ai][bj][m][n] = __builtin_amdgcn_mfma_f32_16x16x32_bf16(At[m][k], Bt_[n][k], acc[ai][bj][m][n], 0, 0, 0); \
    __builtin_amdgcn_s_setprio(0); } while (0)
#define WAIT_V(n) asm volatile("s_waitcnt vmcnt(" #n ")" ::: "memory")
#define WAIT_L(n) asm volatile("s_waitcnt lgkmcnt(" #n ")" ::: "memory")
#define BAR __builtin_amdgcn_s_barrier()
#define SCHED __builtin_amdgcn_sched_barrier(0)

template <bool ZERO = true>
__device__ __forceinline__ void gemm256(const ushort_t* __restrict__ A, const ushort_t* __restrict__ Bt, const int K,
                                        LAS ushort_t* shm, f32x4 (&acc)[2][2][4][2]) {
  int tl = threadIdx.x; asm volatile("" : "+v"(tl));
  const int wid = tl >> 6, lane = tl & 63, wr = wid >> 2, wc = wid & 3, fr = lane & 15, fq = lane >> 4;
  const int brow = 0, bcol = 0;
  unsigned so_b[2];
#pragma unroll
  for (int i = 0; i < 2; ++i) { int r_, c_; stage_rc(tl * 16 + i * 8192, r_, c_); so_b[i] = (unsigned)((r_ * K + c_) * 2); }
  bf16x8 At[4][2], B0[2][2], B1[2][2];
  const int nt = K / G_BK;
  if (ZERO) {
#pragma unroll
    for (int a = 0; a < 2; ++a)
#pragma unroll
      for (int b = 0; b < 2; ++b)
#pragma unroll
        for (int m = 0; m < 4; ++m)
#pragma unroll
          for (int n = 0; n < 2; ++n) acc[a][b][m][n] = (f32x4){0.f, 0.f, 0.f, 0.f};
  }
  STAGE(SB(0, 0), Bt, bcol, 0); STAGE(SA(0, 0), A, brow, 0);
  STAGE(SB(0, 1), Bt, bcol + G_HALF, 0); STAGE(SA(0, 1), A, brow + G_HALF, 0);
  if (wr == 1) BAR;
  WAIT_V(4); BAR;
  STAGE(SB(1, 0), Bt, bcol, 1); STAGE(SA(1, 0), A, brow, 1); STAGE(SB(1, 1), Bt, bcol + G_HALF, 1);
  WAIT_V(6); BAR;
  for (int t = 0; t < nt - 2; t += 2) {
    LDB(B0, 0, 0); SCHED; LDA(At, 0, 0); STAGE(SA(1, 1), A, brow + G_HALF, t + 1);
    WAIT_L(8); BAR; WAIT_L(0); MMA(0, 0, At, B0); BAR; SCHED;
    LDB(B1, 0, 1); STAGE(SB(0, 0), Bt, bcol, t + 2);
    BAR; WAIT_L(0); MMA(0, 1, At, B1); BAR;
    LDA(At, 0, 1); STAGE(SA(0, 0), A, brow, t + 2);
    BAR; WAIT_L(0); MMA(1, 0, At, B0); BAR; SCHED;
    STAGE(SB(0, 1), Bt, bcol + G_HALF, t + 2);
    WAIT_V(6); BAR; MMA(1, 1, At, B1); BAR;
    LDB(B0, 1, 0); SCHED; LDA(At, 1, 0); STAGE(SA(0, 1), A, brow + G_HALF, t + 2);
    WAIT_L(8); BAR; WAIT_L(0); MMA(0, 0, At, B0); BAR; SCHED;
    LDB(B1, 1, 1); STAGE(SB(1, 0), Bt, bcol, t + 3);
    BAR; WAIT_L(0); MMA(0, 1, At, B1); BAR;
    LDA(At, 1, 1); STAGE(SA(1, 0), A, brow, t + 3);
    BAR; WAIT_L(0); MMA(1, 0, At, B0); BAR; SCHED;
    STAGE(SB(1, 1), Bt, bcol + G_HALF, t + 3);
    WAIT_V(6); BAR; MMA(1, 1, At, B1); BAR;
  }
  { LDB(B0, 0, 0); LDA(At, 0, 0); STAGE(SA(1, 1), A, brow + G_HALF, nt - 1);
    BAR; WAIT_L(0); MMA(0, 0, At, B0); BAR;
    LDB(B1, 0, 1); BAR; WAIT_L(0); MMA(0, 1, At, B1); BAR;
    LDA(At, 0, 1); WAIT_V(4); BAR; WAIT_L(0); MMA(1, 0, At, B0); MMA(1, 1, At, B1); BAR; }
  { LDB(B0, 1, 0); LDA(At, 1, 0); WAIT_V(2); BAR; WAIT_L(0); MMA(0, 0, At, B0); BAR;
    LDB(B1, 1, 1); WAIT_V(0); BAR; WAIT_L(0); MMA(0, 1, At, B1); BAR;
    LDA(At, 1, 1); BAR; WAIT_L(0); MMA(1, 0, At, B0); MMA(1, 1, At, B1); BAR; }
  if (wr == 0) BAR;
}

#define LAUNDER_IDX() int tl_ = threadIdx.x; asm volatile("" : "+v"(tl_)); \
  const int wid = tl_ >> 6, lane = tl_ & 63, wr = wid >> 2, wc = wid & 3, fr = lane & 15, fq = lane >> 4; (void)lane;
#define ACC_FOREACH_PAIR(...) { LAUNDER_IDX() \
  _Pragma("unroll") for (int ai = 0; ai < 2; ++ai) _Pragma("unroll") for (int bj = 0; bj < 2; ++bj) \
  _Pragma("unroll") for (int m = 0; m < 4; ++m) { \
    const int R = ai * 128 + wr * 64 + m * 16 + fq * 4; const int Cb = bj * 128 + wc * 32 + fr; \
    const int Rw = ai * 128 + wr * 64 + m * 16 + (fq >> 1) * 8; const int Tw = bj * 128 + wc * 32 + (fq & 1) * 16 + fr; \
    (void)R; (void)Cb; (void)Rw; (void)Tw; \
    f32x4& v0 = acc[ai][bj][m][0]; f32x4& v1 = acc[ai][bj][m][1]; __VA_ARGS__ } }
#define ACC_FOREACH(...) { LAUNDER_IDX() \
  _Pragma("unroll") for (int ai = 0; ai < 2; ++ai) _Pragma("unroll") for (int bj = 0; bj < 2; ++bj) \
  _Pragma("unroll") for (int m = 0; m < 4; ++m) _Pragma("unroll") for (int n = 0; n < 2; ++n) { \
    const int R = ai * 128 + wr * 64 + m * 16 + fq * 4; const int Cc = bj * 128 + wc * 32 + n * 16 + fr; \
    f32x4& v = acc[ai][bj][m][n]; __VA_ARGS__ } }

__device__ __forceinline__ void tile_map(int L, int nM, int nN, int& pm, int& pn) {
  const int nwg = nM * nN, q = nwg / 8, r = nwg % 8, xcd = L % 8, off = L / 8;
  const int wgid = (xcd < r ? xcd * (q + 1) : r * (q + 1) + (xcd - r) * q) + off;
  const int nig = 8 * nN, gid = wgid / nig, fm = gid * 8, gsz = (nM - fm) < 8 ? (nM - fm) : 8;
  pm = fm + ((wgid % nig) % gsz); pn = (wgid % nig) / gsz;
}

__device__ __forceinline__ void phase1(const Params& p, LAS ushort_t* shm) {
  const ushort_t* xn = (const ushort_t*)(p.ws + WS_XN);
  const ushort_t* wtin = (const ushort_t*)(p.ws + WS_WTIN);
  ushort_t* qA = (ushort_t*)(p.ws + WS_QA);
  ushort_t* kA = (ushort_t*)(p.ws + WS_KA);
  ushort_t* vtp = (ushort_t*)(p.ws + WS_VTP);
  ushort_t* vts = (ushort_t*)(p.ws + WS_VTS);
  ushort_t* dgs = (ushort_t*)(p.ws + WS_DGS);
  ushort_t* gqk = (ushort_t*)(p.ws + WS_GQK);
  ushort_t* gvtp = (ushort_t*)(p.ws + WS_GVTP);
  ushort_t* gvts = (ushort_t*)(p.ws + WS_GVTS);
  ushort_t* ggs = (ushort_t*)(p.ws + WS_GGS);
  float* gaf = (float*)(p.ws + WS_GAF);
  ushort_t* mgs = (ushort_t*)(p.ws + WS_MGS);
  const int NTN = 22;
  const int NTM = TT / 256;
  for (int it = blockIdx.x; it < NTN * NTM; it += gridDim.x) {
    int nt, mt; tile_map(it, NTM, NTN, mt, nt);
    const int n0 = nt * 256, t0 = mt * 256;
    const bool isS = t0 >= TP;
    f32x4 acc[2][2][4][2];
    const bool vseg = (nt == 4 || nt == 5 || nt == 10 || nt == 11);
    if (vseg) gemm256(xn + (size_t)t0 * DM, wtin + (size_t)n0 * DM, DM, shm, acc);
    else gemm256(wtin + (size_t)n0 * DM, xn + (size_t)t0 * DM, DM, shm, acc);

    if (vseg) {
      const bool isDv = nt < 6;
      const int nb = isDv ? 1024 : 2560;
      ACC_FOREACH_PAIR({
        const int t = t0 + R;
        if (isDv) {
          const int nv = n0 - nb + Cb;
          float* o = isS ? (p.out + O_VS + (size_t)(t - TP) * 512 + nv) : (p.out + O_VP + (size_t)t * 512 + nv);
          __builtin_nontemporal_store(v0[0], o); __builtin_nontemporal_store(v0[1], o + 512);
          __builtin_nontemporal_store(v0[2], o + 1024); __builtin_nontemporal_store(v0[3], o + 1536);
          __builtin_nontemporal_store(v1[0], o + 16); __builtin_nontemporal_store(v1[1], o + 528);
          __builtin_nontemporal_store(v1[2], o + 1040); __builtin_nontemporal_store(v1[3], o + 1552);
        }
        const u32x4 pk = widen16(pack4(v0[0], v0[1], v0[2], v0[3]), pack4(v1[0], v1[1], v1[2], v1[3]));
        const int nvw = n0 - nb + Tw;
        const int hh = nvw >> 7, dv = nvw & 127;
        const int tw = t0 + Rw;
        if (!isS) {
          const int b = tw >> 13, tt = tw & 8191;
          ushort_t* dst = (isDv ? vtp : gvtp) + ((size_t)((b * 4 + hh) * 128 + dv)) * 8192 + tt;
          *(u32x4*)dst = pk;
        } else {
          const int ts = tw - TP; const int b = ts >> 5, tt = ts & 31;
          ushort_t* dst = (isDv ? vts : gvts) + ((size_t)((b * 4 + hh) * 128 + dv)) * 32 + tt;
          *(u32x4*)dst = pk;
        }
      })
    } else {
      if (nt < 14) {
        ACC_FOREACH_PAIR({
          u32x2 p0, p1;
          ushort_t* dst;
          if (nt < 2) {
            p0 = pack4(v0[0] * QSCALE, v0[1] * QSCALE, v0[2] * QSCALE, v0[3] * QSCALE);
            p1 = pack4(v1[0] * QSCALE, v1[1] * QSCALE, v1[2] * QSCALE, v1[3] * QSCALE);
            dst = qA + (size_t)(t0 + Tw) * 512 + n0 + Rw;
          } else if (nt < 4) {
            const int nk = n0 + R - 512;
            const int ta = t0 + Cb, tb = t0 + Cb + 16;
            float* oa_ = isS ? (p.out + O_KS + (size_t)(ta - TP) * 512 + nk) : (p.out + O_KP + (size_t)ta * 512 + nk);
            float* ob_ = isS ? (p.out + O_KS + (size_t)(tb - TP) * 512 + nk) : (p.out + O_KP + (size_t)tb * 512 + nk);
            __builtin_nontemporal_store(v0, (f32x4*)oa_); __builtin_nontemporal_store(v1, (f32x4*)ob_);
            p0 = pack4(v0[0], v0[1], v0[2], v0[3]);
            p1 = pack4(v1[0], v1[1], v1[2], v1[3]);
            dst = kA + (size_t)(t0 + Tw) * 512 + n0 + Rw - 512;
          } else if (nt < 8) {
            p0 = pack4(silu_f(v0[0]), silu_f(v0[1]), silu_f(v0[2]), silu_f(v0[3]));
            p1 = pack4(silu_f(v1[0]), silu_f(v1[1]), silu_f(v1[2]), silu_f(v1[3]));
            dst = dgs + (size_t)(t0 + Tw) * 512 + n0 + Rw - 1536;
          } else if (nt < 10) {
            const float sc = (nt == 8) ? 0.125f : 1.f;
            p0 = pack4(v0[0] * sc, v0[1] * sc, v0[2] * sc, v0[3] * sc);
            p1 = pack4(v1[0] * sc, v1[1] * sc, v1[2] * sc, v1[3] * sc);
            dst = gqk + (size_t)(t0 + Tw) * 512 + n0 + Rw - 2048;
          } else {
            p0 = pack4(silu_f(v0[0]), silu_f(v0[1]), silu_f(v0[2]), silu_f(v0[3]));
            p1 = pack4(silu_f(v1[0]), silu_f(v1[1]), silu_f(v1[2]), silu_f(v1[3]));
            dst = ggs + (size_t)(t0 + Tw) * 512 + n0 + Rw - 3072;
          }
          *(u32x4*)dst = widen16(p0, p1);
        })
      }
      if (nt >= 14 && nt < 22) {
        LAUNDER_IDX()
#pragma unroll
        for (int bj = 0; bj < 2; ++bj)
#pragma unroll
          for (int m = 0; m < 4; ++m) {
            u32x2 prt[2], pgb[2];
#pragma unroll
            for (int n = 0; n < 2; ++n) {
              const f32x4 va = acc[0][bj][m][n], vb = acc[1][bj][m][n];
              float rt[4], gb[4];
#pragma unroll
              for (int j = 0; j < 4; ++j) {
                const float ea = 1.f + __expf(-va[j]), eb = 1.f + __expf(-vb[j]);
                gb[j] = __builtin_amdgcn_rcpf(eb);
                rt[j] = eb * __builtin_amdgcn_rcpf(ea);
              }
              prt[n] = pack4(rt[0], rt[1], rt[2], rt[3]);
              pgb[n] = pack4(gb[0], gb[1], gb[2], gb[3]);
            }
            const int tw = t0 + bj * 128 + wc * 32 + (fq & 1) * 16 + fr;
            const int ccw = (nt - 14) * 128 + wr * 64 + m * 16 + (fq >> 1) * 8;
            *(u32x4*)(mgs + (size_t)tw * 2048 + ccw) = widen16(prt[0], prt[1]);
            *(u32x4*)(mgs + (size_t)tw * 2048 + 1024 + ccw) = widen16(pgb[0], pgb[1]);
          }
      }
    }
  }
  {
    const int G = gridDim.x;
    const int first = (NTN * NTM) % G;
    const int nb = (first == 0) ? G : (G - first);
    const int me = (int)blockIdx.x - ((first == 0) ? 0 : first);
    if (me >= 0) {
      const int tl = ltid();
      const int wv = tl >> 6, ln = tl & 63, fr = ln & 15, fq = ln >> 4;
      for (int j = me; j < NTM; j += nb) {
        const int t0 = j * 256 + wv * 32;
        const ushort_t* ap = wtin + (size_t)(5632 + fr) * DM + fq * 8;
        const ushort_t* bp0 = xn + (size_t)(t0 + fr) * DM + fq * 8;
        const ushort_t* bp1 = bp0 + (size_t)16 * DM;
        f32x4 c0 = {0.f, 0.f, 0.f, 0.f}, c1 = {0.f, 0.f, 0.f, 0.f};
#pragma unroll 1
        for (int kb = 0; kb < 32; kb += 8) {
          bf16x8 af[8], b0[8], b1[8];
#pragma unroll
          for (int u = 0; u < 8; ++u) {
            af[u] = *(const bf16x8*)(ap + (kb + u) * 32);
            b0[u] = *(const bf16x8*)(bp0 + (kb + u) * 32);
            b1[u] = *(const bf16x8*)(bp1 + (kb + u) * 32);
          }
#pragma unroll
          for (int u = 0; u < 8; ++u) {
            c0 = __builtin_amdgcn_mfma_f32_16x16x32_bf16(af[u], b0[u], c0, 0, 0, 0);
            c1 = __builtin_amdgcn_mfma_f32_16x16x32_bf16(af[u], b1[u], c1, 0, 0, 0);
          }
        }
        *(f32x4*)(gaf + (size_t)(t0 + fr) * 16 + fq * 4) = c0;
        *(f32x4*)(gaf + (size_t)(t0 + 16 + fr) * 16 + fq * 4) = c1;
      }
    }
  }
}

#define RESCALE_THR 8.0f
#define KLD 136
#define VLD 72
#define ABUF (64 * KLD + 128 * VLD)

__device__ __forceinline__ void attn_compute_tile(const ushort_t* sK, const ushort_t* sVT, int map, int nu, const bf16x8 (&qf)[4],
                                                  f32x16 (&O)[4], f32x16& Mi, bool first, float& l, int lane) {
  const int r = lane & 31, hh = lane >> 5;
  f32x16 S0, S1;
#pragma unroll
  for (int i = 0; i < 16; ++i) S1[i] = 0.f;
  const ushort_t* kp = sK + r * KLD + map * 64 + 8 * hh;
  const ushort_t* vp = sVT + r * VLD + 8 * hh;
  bf16x8 kf0[4], kf1[4];
#pragma unroll
  for (int s = 0; s < 4; ++s) kf0[s] = *(const bf16x8*)(kp + 16 * s);
  if (nu > 1) {
#pragma unroll
    for (int s = 0; s < 4; ++s) kf1[s] = *(const bf16x8*)(kp + 32 * KLD + 16 * s);
  }
  S0 = MFMA32(kf0[0], qf[0], Mi);
  if (nu > 1) S1 = MFMA32(kf1[0], qf[0], Mi);
#pragma unroll
  for (int s = 1; s < 4; ++s) {
    S0 = MFMA32(kf0[s], qf[s], S0);
    if (nu > 1) S1 = MFMA32(kf1[s], qf[s], S1);
  }
  bf16x8 vf0[2][4];
#pragma unroll
  for (int s2 = 0; s2 < 2; ++s2)
#pragma unroll
    for (int w4 = 0; w4 < 4; ++w4) vf0[s2][w4] = *(const bf16x8*)(vp + 32 * w4 * VLD + 16 * s2);
  float mx = S0[0];
#pragma unroll
  for (int i = 1; i < 16; ++i) mx = fmaxf(mx, S0[i]);
  if (nu > 1) {
#pragma unroll
    for (int i = 0; i < 16; ++i) mx = fmaxf(mx, S1[i]);
  }
  mx = xmax32(mx);
  if (first || __any(mx > RESCALE_THR)) {
    const float d = first ? mx : fmaxf(mx, 0.f);
    if (!first) {
      const float alpha = __builtin_amdgcn_exp2f(-d);
      l *= alpha;
#pragma unroll
      for (int w4 = 0; w4 < 4; ++w4)
#pragma unroll
        for (int i = 0; i < 16; ++i) O[w4][i] *= alpha;
    }
#pragma unroll
    for (int i = 0; i < 16; ++i) { S0[i] -= d; Mi[i] -= d; }
    if (nu > 1) {
#pragma unroll
      for (int i = 0; i < 16; ++i) S1[i] -= d;
    }
  }
  float ps = 0.f;
#pragma unroll
  for (int i = 0; i < 16; ++i) { S0[i] = __builtin_amdgcn_exp2f(S0[i]); ps += S0[i]; }
  if (nu > 1) {
#pragma unroll
    for (int i = 0; i < 16; ++i) { S1[i] = __builtin_amdgcn_exp2f(S1[i]); ps += S1[i]; }
  }
  l += ps;
  bf16x8 vf1[2][4];
  if (nu > 1) {
#pragma unroll
    for (int s2 = 0; s2 < 2; ++s2)
#pragma unroll
      for (int w4 = 0; w4 < 4; ++w4) vf1[s2][w4] = *(const bf16x8*)(vp + 32 * w4 * VLD + 32 + 16 * s2);
  }
#pragma unroll
  for (int s2 = 0; s2 < 2; ++s2) {
    union { bf16x8 v; unsigned u[4]; } pb;
#pragma unroll
    for (int j = 0; j < 4; ++j) pb.u[j] = pack2(S0[8 * s2 + 2 * j], S0[8 * s2 + 2 * j + 1]);
#pragma unroll
    for (int w4 = 0; w4 < 4; ++w4) O[w4] = MFMA32(vf0[s2][w4], pb.v, O[w4]);
  }
  if (nu > 1) {
#pragma unroll
    for (int s2 = 0; s2 < 2; ++s2) {
      union { bf16x8 v; unsigned u[4]; } pb;
#pragma unroll
      for (int j = 0; j < 4; ++j) pb.u[j] = pack2(S1[8 * s2 + 2 * j], S1[8 * s2 + 2 * j + 1]);
#pragma unroll
      for (int w4 = 0; w4 < 4; ++w4) O[w4] = MFMA32(vf1[s2][w4], pb.v, O[w4]);
    }
  }
}

__device__ __forceinline__ int vpos(int key) { return (key & 0x30) | ((key & 4) << 1) | ((key & 8) >> 1) | (key & 3); }

__device__ __forceinline__ void attn_item(const Params& p, ushort_t* smem, int kind, int b, int h, int qp, float lam) {
  int tid_l = threadIdx.x; asm volatile("" : "+v"(tid_l));
  const int tid = tid_l, lane = tid & 63, w = tid >> 6;
  const int map = w & 1, rg = w >> 1;
  const int r = lane & 31, hh = lane >> 5;
  const ushort_t* qA = (const ushort_t*)(p.ws + WS_QA);
  const ushort_t* kA = (const ushort_t*)(p.ws + WS_KA);
  const ushort_t* vtp = (const ushort_t*)(p.ws + WS_VTP);
  const ushort_t* vts = (const ushort_t*)(p.ws + WS_VTS);
  const ushort_t* dgs = (const ushort_t*)(p.ws + WS_DGS);
  ushort_t* oaf = (ushort_t*)(p.ws + WS_OAF);
  const bool active = (kind == 0) || (rg == 0);
  const int qtok0 = (kind == 0) ? (b * 8192 + qp * 128) : (TP + b * 32);
  const int ntiles = (kind == 0) ? (2 * qp + 2) : 33;
  const int mytiles = (kind == 0) ? (2 * qp + 1 + (rg >> 1)) : 33;

  bf16x8 qf[4];
  {
    const int tok = qtok0 + (active ? rg : 0) * 32 + r;
#pragma unroll
    for (int s = 0; s < 4; ++s) qf[s] = *(const bf16x8*)(qA + (size_t)tok * 512 + h * 128 + map * 64 + 16 * s + 8 * hh);
  }
  f32x16 O[4];
#pragma unroll
  for (int w4 = 0; w4 < 4; ++w4)
#pragma unroll
    for (int i = 0; i < 16; ++i) O[w4][i] = 0.f;
  float l = 0.f;
  f32x16 Mi;
#pragma unroll
  for (int i = 0; i < 16; ++i) Mi[i] = 0.f;

  __syncthreads();
  if (kind == 0) {
    const size_t kbase = ((size_t)b * 8192) * 512 + h * 128;
    const size_t vbase = ((size_t)(b * 4 + h) * 128) * 8192;
    const int id0 = tid, id1 = tid + 512;
    const int kso0 = (id0 >> 4) * KLD + (id0 & 15) * 8, kso1 = (id1 >> 4) * KLD + (id1 & 15) * 8;
    const int vso0 = 64 * KLD + (id0 >> 3) * VLD + ((id0 & 6) << 3) + ((id0 & 1) << 2);
    const int vso1 = 64 * KLD + (id1 >> 3) * VLD + ((id1 & 6) << 3) + ((id1 & 1) << 2);
    const ushort_t* kg0 = kA + kbase + (size_t)(id0 >> 4) * 512 + (id0 & 15) * 8;
    const ushort_t* kg1 = kA + kbase + (size_t)(id1 >> 4) * 512 + (id1 & 15) * 8;
    const ushort_t* vg0 = vtp + vbase + (size_t)(id0 >> 3) * 8192 + (id0 & 7) * 8;
    const ushort_t* vg1 = vtp + vbase + (size_t)(id1 >> 3) * 8192 + (id1 & 7) * 8;
    u32x4 kr0, kr1, vr0, vr1;
#define ATT_LOAD(T) do { kr0 = *(const u32x4*)(kg0 + (size_t)(T) * 64 * 512); kr1 = *(const u32x4*)(kg1 + (size_t)(T) * 64 * 512); \
                         vr0 = *(const u32x4*)(vg0 + (T) * 64); vr1 = *(const u32x4*)(vg1 + (T) * 64); } while (0)
#define ATT_STORE(BUF) do { ushort_t* _d = (BUF); *(u32x4*)(_d + kso0) = kr0; *(u32x4*)(_d + kso1) = kr1; \
                            *(u32x2*)(_d + vso0) = (u32x2){vr0.x, vr0.y}; *(u32x2*)(_d + vso0 + 8) = (u32x2){vr0.z, vr0.w}; \
                            *(u32x2*)(_d + vso1) = (u32x2){vr1.x, vr1.y}; *(u32x2*)(_d + vso1 + 8) = (u32x2){vr1.z, vr1.w}; } while (0)
    ATT_LOAD(0); ATT_STORE(smem);
    ATT_LOAD(1); ATT_STORE(smem + ABUF);
    __syncthreads();
    const int npairs = qp + 1;
    for (int i = 0; i < npairs; ++i) {
      ushort_t* cur = smem + (i & 1) * 2 * ABUF;
      ushort_t* nxt = smem + ((i + 1) & 1) * 2 * ABUF;
      const bool more = (i + 1 < npairs);
      if (more) ATT_LOAD(2 * i + 2);
      if (2 * i < mytiles) attn_compute_tile(cur, cur + 64 * KLD, map, 2, qf, O, Mi, i == 0, l, lane);
      if (more) { ATT_STORE(nxt); ATT_LOAD(2 * i + 3); }
      if (2 * i + 1 < mytiles) attn_compute_tile(cur + ABUF, cur + ABUF + 64 * KLD, map, 2, qf, O, Mi, false, l, lane);
      if (more) ATT_STORE(nxt + ABUF);
      __syncthreads();
    }
#undef ATT_LOAD
#undef ATT_STORE
  } else {
    f32x4 kr[4], vr[4];
    {
      const float* ck = p.cache_k + ((size_t)(b * 2048) * 4 + h) * 128;
      const float* cv = p.cache_v + ((size_t)(b * 2048) * 4 + h) * 128;
#pragma unroll
      for (int i = 0; i < 4; ++i) {
        const int id = tid + 512 * i;
        kr[i] = __builtin_nontemporal_load((const f32x4*)(ck + (size_t)(id >> 5) * 512 + (id & 31) * 4));
      }
#pragma unroll
      for (int i = 0; i < 2; ++i) {
        const int id = tid + 512 * i;
        vr[2 * i] = __builtin_nontemporal_load((const f32x4*)(cv + (size_t)(2 * (id >> 5)) * 512 + (id & 31) * 4));
        vr[2 * i + 1] = __builtin_nontemporal_load((const f32x4*)(cv + (size_t)(2 * (id >> 5) + 1) * 512 + (id & 31) * 4));
      }
    }
    for (int t = 0; t < 33; ++t) {
      ushort_t* cb = smem + (t & 1) * ABUF;
      if (t < 32) {
#pragma unroll
        for (int i = 0; i < 4; ++i) {
          const int id = tid + 512 * i;
          *(u32x2*)(cb + (id >> 5) * KLD + (id & 31) * 4) = pack4(kr[i].x, kr[i].y, kr[i].z, kr[i].w);
        }
#pragma unroll
        for (int i = 0; i < 2; ++i) {
          const int id = tid + 512 * i;
          const int key = 2 * (id >> 5), dv = (id & 31) * 4;
          ushort_t* vd = cb + 64 * KLD + dv * VLD + vpos(key);
          const f32x4 va = vr[2 * i], vb = vr[2 * i + 1];
          *(unsigned*)vd = pack2(va.x, vb.x); *(unsigned*)(vd + VLD) = pack2(va.y, vb.y);
          *(unsigned*)(vd + 2 * VLD) = pack2(va.z, vb.z); *(unsigned*)(vd + 3 * VLD) = pack2(va.w, vb.w);
        }
      } else {
        const int id = tid;
        u32x4 kv = *(const u32x4*)(kA + (size_t)(TP + b * 32 + (id >> 4)) * 512 + h * 128 + (id & 15) * 8);
        *(u32x4*)(cb + (id >> 4) * KLD + (id & 15) * 8) = kv;
        u32x4 vv = *(const u32x4*)(vts + ((size_t)(b * 4 + h) * 128 + (id >> 2)) * 32 + (id & 3) * 8);
        ushort_t* vd = cb + 64 * KLD + (id >> 2) * VLD + ((id & 2) << 3) + ((id & 1) << 2);
        *(u32x2*)vd = (u32x2){vv.x, vv.y};
        *(u32x2*)(vd + 8) = (u32x2){vv.z, vv.w};
      }
      if (t + 1 < 32) {
        const float* ck = p.cache_k + ((size_t)(b * 2048 + (t + 1) * 64) * 4 + h) * 128;
        const float* cv = p.cache_v + ((size_t)(b * 2048 + (t + 1) * 64) * 4 + h) * 128;
#pragma unroll
        for (int i = 0; i < 4; ++i) {
          const int id = tid + 512 * i;
          kr[i] = __builtin_nontemporal_load((const f32x4*)(ck + (size_t)(id >> 5) * 512 + (id & 31) * 4));
        }
#pragma unroll
        for (int i = 0; i < 2; ++i) {
          const int id = tid + 512 * i;
          vr[2 * i] = __builtin_nontemporal_load((const f32x4*)(cv + (size_t)(2 * (id >> 5)) * 512 + (id & 31) * 4));
          vr[2 * i + 1] = __builtin_nontemporal_load((const f32x4*)(cv + (size_t)(2 * (id >> 5) + 1) * 512 + (id & 31) * 4));
        }
      }
      __syncthreads();
      if (active) attn_compute_tile(cb, cb + 64 * KLD, map, (t < 32) ? 2 : 1, qf, O, Mi, t == 0, l, lane);
    }
    __syncthreads();
  }

  {
    float a = p.lq1[lane] * p.lk1[lane];
    float bq = p.lq2[lane] * p.lk2[lane];
    a = wave_sum(a); bq = wave_sum(bq);
    lam = __expf(a) - __expf(bq) + 0.2f;
  }
  l += __shfl_xor(l, 32);
  const float inv = 1.f / l;
  float* sEx = (float*)smem;
  if (active && map == 1) {
#pragma unroll
    for (int w4 = 0; w4 < 4; ++w4)
#pragma unroll
      for (int i = 0; i < 16; ++i) {
        const int dv = 32 * w4 + (i & 3) + 8 * (i >> 2) + 4 * hh;
        sEx[(rg * 128 + dv) * 32 + r] = O[w4][i] * inv;
      }
  }
  __syncthreads();
  if (active && map == 0) {
    float ssq = 0.f;
#pragma unroll
    for (int w4 = 0; w4 < 4; ++w4)
#pragma unroll
      for (int i = 0; i < 16; ++i) {
        const int dv = 32 * w4 + (i & 3) + 8 * (i >> 2) + 4 * hh;
        const float o = O[w4][i] * inv - lam * sEx[(rg * 128 + dv) * 32 + r];
        O[w4][i] = o;
        ssq += o * o;
      }
    ssq += __shfl_xor(ssq, 32);
    const float rn = rsqrtf(ssq * (1.f / 128.f) + EPS) * 0.8f;
    const int tok = qtok0 + rg * 32 + r;
#pragma unroll
    for (int w4 = 0; w4 < 4; ++w4)
#pragma unroll
      for (int i4 = 0; i4 < 4; ++i4) {
        const int dv0 = 32 * w4 + 8 * i4 + 4 * hh;
        const f32x4 g = *(const f32x4*)(p.da_norm_g + dv0);
        const u32x2 sg = *(const u32x2*)(dgs + (size_t)tok * 512 + h * 128 + dv0);
        *(u32x2*)(oaf + (size_t)tok * 512 + h * 128 + dv0) =
            pack4(O[w4][4 * i4] * rn * g.x * bflo(sg.x), O[w4][4 * i4 + 1] * rn * g.y * bfhi(sg.x),
                  O[w4][4 * i4 + 2] * rn * g.z * bflo(sg.y), O[w4][4 * i4 + 3] * rn * g.w * bfhi(sg.y));
      }
  }
  __syncthreads();
}

#define GLD 72
#define GLA_PREP_FLOATS (1024 + 1024 + 512 + 64)
__device__ __forceinline__ void gla_prep(const Params& p, float* sp, int tok0, int C, int h, float (&bv)[8], float& blast) {
  const int tid = ltid();
  const int k = tid & 63, sq = tid >> 6;
  const float* gaf = (const float*)(p.ws + WS_GAF);
  float* sGa = sp; float* sWu = sp + 1024; float* sSeg = sp + 2048;
  __syncthreads();
  if (tid < 256) {
    const int t = tid >> 2;
    f32x4 v = (t < C) ? *(const f32x4*)(gaf + (size_t)(tok0 + t) * 16 + (tid & 3) * 4) : mkf4(0.f, 0.f, 0.f, 0.f);
    *(f32x4*)(sGa + t * 16 + (tid & 3) * 4) = v;
  }
#pragma unroll
  for (int i = 0; i < 2; ++i) {
    const int id = tid + 512 * i;
    sWu[id] = p.w_alpha_up[(id >> 6) * 256 + h * 64 + (id & 63)];
  }
  __syncthreads();
  const float ba = p.b_alpha[h * 64 + k];
  float wu[16];
#pragma unroll
  for (int rr = 0; rr < 16; ++rr) wu[rr] = sWu[rr * 64 + k];
  float run = 0.f;
#pragma unroll
  for (int e = 0; e < 8; ++e) {
    const int t = sq * 8 + e;
    float z = ba;
#pragma unroll
    for (int rr = 0; rr < 16; ++rr) z += sGa[t * 16 + rr] * wu[rr];
    float la = (fminf(z, 0.f) - __logf(1.f + __expf(-fabsf(z)))) * (1.f / 16.f);
    if (t >= C) la = 0.f;
    run += la;
    bv[e] = run;
  }
  sSeg[sq * 64 + k] = run;
  __syncthreads();
  float off = 0.f, tot = 0.f;
#pragma unroll
  for (int s = 0; s < 8; ++s) {
    const float v = sSeg[s * 64 + k];
    if (s < sq) off += v;
    tot += v;
  }
#pragma unroll
  for (int e = 0; e < 8; ++e) bv[e] += off;
  blast = tot;
}

__device__ __forceinline__ void gla_load_vt(const Params& p, ushort_t* sVT, int kind, int b, int c, int h) {
  const int tid = ltid();
  const ushort_t* gvtp = (const ushort_t*)(p.ws + WS_GVTP);
  const ushort_t* gvts = (const ushort_t*)(p.ws + WS_GVTS);
#pragma unroll
  for (int i = 0; i < 2; ++i) {
    const int id = tid + 512 * i;
    const int row = id >> 3, c16 = id & 7;
    u32x4 v;
    if (kind == 0) v = *(const u32x4*)(gvtp + ((size_t)(b * 4 + h) * 128 + row) * 8192 + c * 64 + c16 * 8);
    else v = (c16 < 4) ? *(const u32x4*)(gvts + ((size_t)(b * 4 + h) * 128 + row) * 32 + c16 * 8) : (u32x4){0, 0, 0, 0};
    *(u32x4*)(sVT + row * GLD + c16 * 8) = v;
  }
}

__device__ __forceinline__ void gla_a_item(const Params& p, float* smemf, int kind, int b, int c, int h) {
  int tid_l = threadIdx.x; asm volatile("" : "+v"(tid_l));
  const int tid = tid_l, lane = tid & 63, w = tid >> 6;
  const int k = tid & 63, sq = tid >> 6;
  const int r = lane & 31, hh = lane >> 5;
  const int vs = w >> 1, ks = w & 1;
  const ushort_t* gqk = (const ushort_t*)(p.ws + WS_GQK);
  float* glat = (float*)(p.ws + WS_GLAT);
  float* glad = (float*)(p.ws + WS_GLAD);
  ushort_t* sKd = (ushort_t*)(smemf + GLA_PREP_FLOATS);
  ushort_t* sVT = sKd + 64 * GLD;
  float* sD = smemf + 2048 + 512;
  const int C = (kind == 0) ? 64 : 32;
  const int tok0 = (kind == 0) ? (b * 8192 + c * 64) : (TP + b * 32);
  float bv[8], blast;
  gla_prep(p, smemf, tok0, C, h, bv, blast);
  if (kind == 0) {
    float* bcum = (float*)(p.ws + WS_BCUM);
#pragma unroll
    for (int e = 0; e < 8; ++e) bcum[(size_t)(tok0 + sq * 8 + e) * 256 + h * 64 + k] = bv[e];
  }
  {
    unsigned pk[4];
#pragma unroll
    for (int e = 0; e < 8; e += 2) {
      const int t = sq * 8 + e;
      float a0 = 0.f, a1 = 0.f;
      if (t < C) {
        a0 = bf2f(gqk[(size_t)(tok0 + t) * 512 + 256 + h * 64 + k]) * __expf(blast - bv[e]);
        a1 = bf2f(gqk[(size_t)(tok0 + t + 1) * 512 + 256 + h * 64 + k]) * __expf(blast - bv[e + 1]);
      }
      pk[e >> 1] = pack2(a0, a1);
    }
    *(u32x4*)(sKd + k * GLD + sq * 8) = (u32x4){pk[0], pk[1], pk[2], pk[3]};
  }
  if (tid < 64) sD[tid] = __expf(blast);
  gla_load_vt(p, sVT, kind, b, c, h);
  __syncthreads();
  f32x16 acc;
#pragma unroll
  for (int i = 0; i < 16; ++i) acc[i] = 0.f;
#pragma unroll
  for (int s = 0; s < 4; ++s) {
    bf16x8 af = *(const bf16x8*)(sVT + (32 * vs + r) * GLD + 16 * s + 8 * hh);
    bf16x8 bfr = *(const bf16x8*)(sKd + (32 * ks + r) * GLD + 16 * s + 8 * hh);
    acc = MFMA32(af, bfr, acc);
  }
  if (kind == 0) {
    const int item = (b * 128 + c) * 4 + h;
    float* dst = glat + (size_t)item * 8192;
#pragma unroll
    for (int i = 0; i < 16; ++i) {
      const int v = 32 * vs + (i & 3) + 8 * (i >> 2) + 4 * hh;
      __builtin_nontemporal_store(acc[i], &dst[v * 64 + 32 * ks + r]);
    }
    if (tid < 64) glad[item * 64 + tid] = sD[tid];
  } else {
    const int kk = 32 * ks + r;
    const float d = sD[kk];
#pragma unroll
    for (int i4 = 0; i4 < 4; ++i4) {
      const int v0 = 32 * vs + 8 * i4 + 4 * hh;
      const size_t idx = ((size_t)(b * 4 + h) * 64 + kk) * 128 + v0;
      const f32x4 s0 = *(const f32x4*)(p.state_gla + idx);
      *(f32x4*)(p.out + O_GS + idx) = mkf4(d * s0.x + acc[4 * i4], d * s0.y + acc[4 * i4 + 1],
                                            d * s0.z + acc[4 * i4 + 2], d * s0.w + acc[4 * i4 + 3]);
    }
  }

}

__device__ __forceinline__ void p5_tile(const Params& p, LAS ushort_t* shm, int mt, int nt);
__device__ __forceinline__ void p6_tile(const Params& p, LAS ushort_t* shm, int mt, int nt);
__device__ __forceinline__ void phase3(const Params& p, LAS ushort_t* shm) {
  const float* glat = (const float*)(p.ws + WS_GLAT);
  const float* glad = (const float*)(p.ws + WS_GLAD);
  ushort_t* glas = (ushort_t*)(p.ws + WS_GLAS);
  const int tid = ltid();
  const int G = gridDim.x;
  const int nscan = (G >= 144) ? 128 : G;
  if ((int)blockIdx.x < nscan) {
    for (int e = blockIdx.x * NT + tid; e < 65536; e += nscan * NT) {
      const int bh = e >> 13, vk = e & 8191;
      const int b = bh >> 2, h = bh & 3;
      float S = 0.f;
      for (int c0 = 0; c0 < 128; c0 += 16) {
        float tv[16], dv[16];
#pragma unroll
        for (int u = 0; u < 16; ++u) {
          const int item = (b * 128 + c0 + u) * 4 + h;
          tv[u] = __builtin_nontemporal_load(&glat[(size_t)item * 8192 + vk]);
          dv[u] = glad[item * 64 + (vk & 63)];
        }
#pragma unroll
        for (int u = 0; u < 16; ++u) {
          const int item = (b * 128 + c0 + u) * 4 + h;
          glas[(size_t)item * 8192 + vk] = f2bf(S);
          S = dv[u] * S + tv[u];
        }
      }
      const int v = vk >> 6, k = vk & 63;
      p.out[O_GP + ((size_t)bh * 64 + k) * 128 + v] = S;
    }
  }
  {
    const int first = (G >= 144) ? 128 : 0, nb = (G >= 144) ? (G - 128) : G;
    const int me = (int)blockIdx.x - first;
    if (me >= 0) for (int i = me; i < 16; i += nb) p5_tile(p, shm, 64 + (i >> 2), i & 3);
  }
}

__device__ __forceinline__ void gla_c_item(const Params& p, float* smemf, int kind, int b, int c, int h) {
  int tid_l = threadIdx.x; asm volatile("" : "+v"(tid_l));
  const int tid = tid_l, lane = tid & 63, w = tid >> 6;
  const int k = tid & 63, sq = tid >> 6;
  const int r = lane & 31, hh = lane >> 5;
  const int tg = w & 1, vq = w >> 1;
  const ushort_t* gqk = (const ushort_t*)(p.ws + WS_GQK);
  const ushort_t* glas = (const ushort_t*)(p.ws + WS_GLAS);
  const ushort_t* ggs = (const ushort_t*)(p.ws + WS_GGS);
  ushort_t* obf = (ushort_t*)(p.ws + WS_OBF);
  ushort_t* sQ = (ushort_t*)(smemf + GLA_PREP_FLOATS);
  ushort_t* sKt = sQ + 64 * GLD;
  ushort_t* sVT = sKt + 64 * GLD;
  ushort_t* sST = sVT + 128 * GLD;
  float* sSsq = (float*)(sST + 128 * GLD);
  const int C = (kind == 0) ? 64 : 32;
  const int tok0 = (kind == 0) ? (b * 8192 + c * 64) : (TP + b * 32);
  u32x2 sg_e[4];
  f32x4 g_e[4];
  {
    const int tcol_e = 32 * tg + r;
    const int tok_e = tok0 + ((tcol_e < C) ? tcol_e : 0);
#pragma unroll
    for (int i4 = 0; i4 < 4; ++i4) {
      const int v0 = 32 * vq + 8 * i4 + 4 * hh;
      g_e[i4] = *(const f32x4*)(p.gla_norm_g + v0);
      sg_e[i4] = *(const u32x2*)(ggs + (size_t)tok_e * 512 + h * 128 + v0);
    }
  }
  float bv[8], blast;
  if (kind == 0) {
    const float* bcum = (const float*)(p.ws + WS_BCUM);
#pragma unroll
    for (int e = 0; e < 8; ++e) bv[e] = bcum[(size_t)(tok0 + sq * 8 + e) * 256 + h * 64 + k];
    blast = 0.f;
    __syncthreads();
  } else {
    gla_prep(p, smemf, tok0, C, h, bv, blast);
  }
#pragma unroll
  for (int e = 0; e < 8; ++e) {
    const int t = sq * 8 + e;
    float qv = 0.f, kv = 0.f;
    if (t < C) {
      qv = bf2f(gqk[(size_t)(tok0 + t) * 512 + h * 64 + k]) * __expf(bv[e]);
      kv = bf2f(gqk[(size_t)(tok0 + t) * 512 + 256 + h * 64 + k]) * __expf(-bv[e]);
    }
    sQ[t * GLD + k] = f2bf(qv);
    sKt[t * GLD + k] = f2bf(kv);
  }
  gla_load_vt(p, sVT, kind, b, c, h);
  if (kind == 0) {
    const int item = (b * 128 + c) * 4 + h;
#pragma unroll
    for (int i = 0; i < 2; ++i) {
      const int id = tid + 512 * i;
      const int row = id >> 3, c16 = id & 7;
      *(u32x4*)(sST + row * GLD + c16 * 8) = *(const u32x4*)(glas + (size_t)item * 8192 + row * 64 + c16 * 8);
    }
  } else {
#pragma unroll
    for (int i = 0; i < 4; ++i) {
      const int id = tid + 512 * i;
      const int kk = id >> 5, v0 = (id & 31) * 4;
      const f32x4 s0 = *(const f32x4*)(p.state_gla + ((size_t)(b * 4 + h) * 64 + kk) * 128 + v0);
      sST[(v0 + 0) * GLD + kk] = f2bf(s0.x);
      sST[(v0 + 1) * GLD + kk] = f2bf(s0.y);
      sST[(v0 + 2) * GLD + kk] = f2bf(s0.z);
      sST[(v0 + 3) * GLD + kk] = f2bf(s0.w);
    }
  }
  __syncthreads();
  bf16x8 qf[4];
#pragma unroll
  for (int s = 0; s < 4; ++s) qf[s] = *(const bf16x8*)(sQ + (32 * tg + r) * GLD + 16 * s + 8 * hh);
  f32x16 X0, X1;
#pragma unroll
  for (int i = 0; i < 16; ++i) { X0[i] = 0.f; X1[i] = 0.f; }
#pragma unroll
  for (int s = 0; s < 4; ++s) {
    bf16x8 kf = *(const bf16x8*)(sKt + r * GLD + 16 * s + 8 * hh);
    X0 = MFMA32(kf, qf[s], X0);
  }
  if (tg == 1) {
#pragma unroll
    for (int s = 0; s < 4; ++s) {
      bf16x8 kf = *(const bf16x8*)(sKt + (32 + r) * GLD + 16 * s + 8 * hh);
      X1 = MFMA32(kf, qf[s], X1);
    }
  }
  const int tcol = 32 * tg + r;
#pragma unroll
  for (int i = 0; i < 16; ++i) {
    const int srow = (i & 3) + 8 * (i >> 2) + 4 * hh;
    if (srow > tcol) X0[i] = 0.f;
    if (srow + 32 > tcol) X1[i] = 0.f;
  }
  f32x16 acc;
#pragma unroll
  for (int i = 0; i < 16; ++i) acc[i] = 0.f;
#pragma unroll
  for (int s = 0; s < 4; ++s) {
    bf16x8 af = *(const bf16x8*)(sST + (32 * vq + r) * GLD + 16 * s + 8 * hh);
    acc = MFMA32(af, qf[s], acc);
  }
#pragma unroll
  for (int s2 = 0; s2 < 2; ++s2) {
    union { bf16x8 v; unsigned u[4]; } pb;
#pragma unroll
    for (int j = 0; j < 4; ++j) pb.u[j] = pack2(X0[8 * s2 + 2 * j], X0[8 * s2 + 2 * j + 1]);
    union { bf16x8 v; u32x2 d[2]; } vf;
    const ushort_t* vp = sVT + (32 * vq + r) * GLD + 16 * s2 + 4 * hh;
    vf.d[0] = *(const u32x2*)vp;
    vf.d[1] = *(const u32x2*)(vp + 8);
    acc = MFMA32(vf.v, pb.v, acc);
  }
  if (tg == 1) {
#pragma unroll
    for (int s2 = 0; s2 < 2; ++s2) {
      union { bf16x8 v; unsigned u[4]; } pb;
#pragma unroll
      for (int j = 0; j < 4; ++j) pb.u[j] = pack2(X1[8 * s2 + 2 * j], X1[8 * s2 + 2 * j + 1]);
      union { bf16x8 v; u32x2 d[2]; } vf;
      const ushort_t* vp = sVT + (32 * vq + r) * GLD + 32 + 16 * s2 + 4 * hh;
      vf.d[0] = *(const u32x2*)vp;
      vf.d[1] = *(const u32x2*)(vp + 8);
      acc = MFMA32(vf.v, pb.v, acc);
    }
  }
  float ssq = 0.f;
#pragma unroll
  for (int i = 0; i < 16; ++i) ssq += acc[i] * acc[i];
  ssq += __shfl_xor(ssq, 32);
  if (hh == 0) sSsq[vq * 64 + tcol] = ssq;
  __syncthreads();
  const float tot = sSsq[tcol] + sSsq[64 + tcol] + sSsq[128 + tcol] + sSsq[192 + tcol];
  const float rn = rsqrtf(tot * (1.f / 128.f) + EPS);
  if (tcol < C) {
    const int tok = tok0 + tcol;
#pragma unroll
    for (int i4 = 0; i4 < 4; ++i4) {
      const int v0 = 32 * vq + 8 * i4 + 4 * hh;
      const f32x4 g = g_e[i4];
      const u32x2 sg = sg_e[i4];
      *(u32x2*)(obf + (size_t)tok * 512 + h * 128 + v0) =
          pack4(acc[4 * i4] * rn * g.x * bflo(sg.x), acc[4 * i4 + 1] * rn * g.y * bfhi(sg.x),
                acc[4 * i4 + 2] * rn * g.z * bflo(sg.y), acc[4 * i4 + 3] * rn * g.w * bfhi(sg.y));
    }
  }

}

__device__ __forceinline__ void p5_tile(const Params& p, LAS ushort_t* shm, int mt, int nt) {
  const ushort_t* oaf = (const ushort_t*)(p.ws + WS_OAF);
  const ushort_t* obf = (const ushort_t*)(p.ws + WS_OBF);
  const ushort_t* wat = (const ushort_t*)(p.ws + WS_WAT);
  const ushort_t* wbt = (const ushort_t*)(p.ws + WS_WBT);
  const ushort_t* mgs = (const ushort_t*)(p.ws + WS_MGS);
  ushort_t* mix = (ushort_t*)(p.ws + WS_MIX);
  const int n0 = nt * 256, t0 = mt * 256;
  f32x4 acc[2][2][4][2];
  gemm256(wat + (size_t)n0 * 512, oaf + (size_t)t0 * 512, 512, shm, acc);
  ACC_FOREACH({
    const int t = t0 + Cc; const int nn = n0 + R;
    const u32x2 g = __builtin_nontemporal_load((const u32x2*)(mgs + (size_t)t * 2048 + nn));
    v[0] *= bflo(g.x); v[1] *= bfhi(g.x); v[2] *= bflo(g.y); v[3] *= bfhi(g.y);
  })
  gemm256<false>(wbt + (size_t)n0 * 512, obf + (size_t)t0 * 512, 512, shm, acc);
  ACC_FOREACH_PAIR({
    const int nn = n0 + R;
    const u32x2 gb0 = __builtin_nontemporal_load((const u32x2*)(mgs + (size_t)(t0 + Cb) * 2048 + 1024 + nn));
    const u32x2 gb1 = __builtin_nontemporal_load((const u32x2*)(mgs + (size_t)(t0 + Cb + 16) * 2048 + 1024 + nn));
    const u32x2 p0 = pack4(v0[0] * bflo(gb0.x), v0[1] * bfhi(gb0.x), v0[2] * bflo(gb0.y), v0[3] * bfhi(gb0.y));
    const u32x2 p1 = pack4(v1[0] * bflo(gb1.x), v1[1] * bfhi(gb1.x), v1[2] * bflo(gb1.y), v1[3] * bfhi(gb1.y));
    *(u32x4*)(mix + (size_t)(t0 + Tw) * 1024 + n0 + Rw) = widen16(p0, p1);
  })
}

__device__ __forceinline__ void p6_tile(const Params& p, LAS ushort_t* shm, int mt, int nt) {
  const ushort_t* mix = (const ushort_t*)(p.ws + WS_MIX);
  const ushort_t* wot = (const ushort_t*)(p.ws + WS_WOT);
  const int n0 = nt * 256, t0 = mt * 256;
  f32x4 acc[2][2][4][2];
  gemm256(wot + (size_t)n0 * 1024, mix + (size_t)t0 * 1024, 1024, shm, acc);
  ACC_FOREACH({
    const int t = t0 + Cc; const int nn = n0 + R;
    *(f32x4*)(p.out + (size_t)t * DM + nn) = v;
  })
}

__device__ __forceinline__ void phase5(const Params& p, LAS ushort_t* shm) {
  for (int it = blockIdx.x; it < 256; it += gridDim.x) {
    int nt, mt; tile_map(it, 64, 4, mt, nt);
    p5_tile(p, shm, mt, nt);
  }
}
__device__ __forceinline__ void phase6(const Params& p, LAS ushort_t* shm) {
  for (int it = blockIdx.x; it < 256; it += gridDim.x) {
    int nt, mt; tile_map(it, 64, 4, mt, nt);
    p6_tile(p, shm, mt, nt);
  }
}

__device__ __forceinline__ void phase7(const Params& p) {
  const int tid = ltid(), wave = tid >> 6, lane = tid & 63;
  for (int row = blockIdx.x * 8 + wave; row < TT; row += gridDim.x * 8) {
    float* yr = (row < TP) ? (p.out + O_YP + (size_t)row * DM) : (p.out + O_YS + (size_t)(row - TP) * DM);
    const float* xr = (row < TP) ? (p.x_prompt + (size_t)row * DM) : (p.x_sample + (size_t)(row - TP) * DM);
    f32x4 v[4];
    float ss = 0.f;
#pragma unroll
    for (int i = 0; i < 4; ++i) {
      const f32x4 a = __builtin_nontemporal_load(&((const f32x4*)yr)[lane + 64 * i]);
      const f32x4 x = __builtin_nontemporal_load(&((const f32x4*)xr)[lane + 64 * i]);
      v[i] = mkf4(a.x + x.x, a.y + x.y, a.z + x.z, a.w + x.w);
      ss += v[i].x * v[i].x + v[i].y * v[i].y + v[i].z * v[i].z + v[i].w * v[i].w;
    }
    ss = wave_sum(ss);
    const float rn = rsqrtf(ss * (1.f / DM) + EPS);
#pragma unroll
    for (int i = 0; i < 4; ++i) {
      const f32x4 g = ((const f32x4*)p.norm_final_g)[lane + 64 * i];
      __builtin_nontemporal_store(mkf4(v[i].x * rn * g.x, v[i].y * rn * g.y, v[i].z * rn * g.z, v[i].w * rn * g.w), &((f32x4*)yr)[lane + 64 * i]);
    }
  }
}

#define SMEM_BYTES (4 * ABUF * 2)

template <int PH>
__device__ __forceinline__ void run_phase(const Params& p, unsigned char* smem_raw, int* s_item_p, float lam, int rep = 0) {
  const int tid = ltid();
  ushort_t* smem = (ushort_t*)smem_raw;
  float* smemf = (float*)smem_raw;
  LAS ushort_t* shm = (LAS ushort_t*)smem_raw;
  if (!PH_ON(PH)) return;
  if (PH == 0) {
    phase0(p, smemf);
  } else if (PH == 1) {
    phase1(p, shm);
  } else if (PH == 2) {
    unsigned* qbase = (unsigned*)(p.ws + WS_CTRL) + 8192;
    int q = (int)(xb_xcc_id() & 7u);
    for (;;) {
      __syncthreads();
      if (tid == 0) *s_item_p = (int)atomicAdd(qbase + 64 * q, 1u);
      __syncthreads();
      const int it = *s_item_p;
      if (it >= 240) {
        __syncthreads();
        if (tid == 0) {
          unsigned hv[8];
#pragma unroll
          for (int j = 0; j < 8; ++j) hv[j] = xb_ld(qbase + 64 * ((q + 1 + j) & 7));
          int nq = -1;
#pragma unroll
          for (int j = 7; j >= 0; --j) if (hv[j] < 240u) nq = (q + 1 + j) & 7;
          *s_item_p = nq;
        }
        __syncthreads();
        const int nq = *s_item_p;
        if (nq < 0) break;
        q = nq;
        continue;
      }
      if (it >= 32 && it < 48) {
        const int idx = q * 16 + (it - 32);
        attn_item(p, smem, 1, idx >> 2, idx & 3, 0, lam);
      } else if (it < 80) {
        const int qp = 63 - ((it < 32) ? it : (it - 16));
        attn_item(p, smem, 0, q >> 2, q & 3, qp, lam);
      } else if (it >= 224) {
        const int j = q * 16 + (it - 224);
        gla_c_item(p, smemf, 1, j >> 2, 0, j & 3);
      } else {
        const int g = q * 144 + (it - 80);
        if (g < 1024) {
#if P2SUB & 4
          gla_a_item(p, smemf, 0, g >> 9, (g >> 2) & 127, g & 3);
#endif
        } else {
          const int j = g - 1024;
#if P2SUB & 8
          gla_a_item(p, smemf, 1, j >> 2, 0, j & 3);
#endif
        }
      }
    }
  } else if (PH == 3) {
    phase3(p, shm);
  } else if (PH == 4) {
    const int G = gridDim.x;
    const int ngc = (G >= 32) ? (G - 16) : G;
    if ((int)blockIdx.x < ngc) {
      for (int it = blockIdx.x; it < 1024; it += ngc) gla_c_item(p, smemf, 0, it >> 9, (it >> 2) & 127, it & 3);
    }
    {
      const int first = (G >= 32) ? (G - 16) : 0, nb = (G >= 32) ? 16 : G;
      const int me = (int)blockIdx.x - first;
      if (me >= 0) for (int i = me; i < 16; i += nb) p6_tile(p, shm, 64 + (i >> 2), i & 3);
    }
  } else if (PH == 5) {
    phase5(p, shm);
  } else if (PH == 6) {
    phase6(p, shm);
  } else {
    phase7(p);
  }
}

__global__ void __launch_bounds__(NT, 2) fwd_kernel(Params p) {
  __shared__ __attribute__((aligned(16))) unsigned char smem_raw[SMEM_BYTES + 32];
  int* s_item = (int*)(smem_raw + SMEM_BYTES + 16);
  volatile unsigned* xb_words = (volatile unsigned*)(smem_raw + SMEM_BYTES);
  const int tid = ltid();

  const float lam = 0.f;
#if MK_ONE_LAUNCH
  if (tid == 0) { xb_words[0] = 0u; xb_words[1] = 0u; }
  __syncthreads();
  XcdBarrier xb = xcd_barrier_post((unsigned*)(p.ws + WS_CTRL), xb_words);
  for (int rep = 0; rep < (REP_ON(0) ? 2 : 1); ++rep) { run_phase<0>(p, smem_raw, s_item, lam, rep); xcd_barrier(xb); }
  for (int rep = 0; rep < (REP_ON(1) ? 2 : 1); ++rep) { run_phase<1>(p, smem_raw, s_item, lam, rep); xcd_barrier(xb); }
  for (int rep = 0; rep < (REP_ON(2) ? 2 : 1); ++rep) { run_phase<2>(p, smem_raw, s_item, lam, rep); xcd_barrier(xb); }
  for (int rep = 0; rep < (REP_ON(3) ? 2 : 1); ++rep) { run_phase<3>(p, smem_raw, s_item, lam, rep); xcd_barrier(xb); }
  for (int rep = 0; rep < (REP_ON(4) ? 2 : 1); ++rep) { run_phase<4>(p, smem_raw, s_item, lam, rep); xcd_barrier(xb); }
  for (int rep = 0; rep < (REP_ON(5) ? 2 : 1); ++rep) { run_phase<5>(p, smem_raw, s_item, lam, rep); xcd_barrier(xb); }
  for (int rep = 0; rep < (REP_ON(6) ? 2 : 1); ++rep) { run_phase<6>(p, smem_raw, s_item, lam, rep); xcd_barrier(xb); }
  run_phase<7>(p, smem_raw, s_item, lam);
#else
  switch (p.phase_lo) {
    case 0: run_phase<0>(p, smem_raw, s_item, lam); break;
    case 1: run_phase<1>(p, smem_raw, s_item, lam); break;
    case 2: run_phase<2>(p, smem_raw, s_item, lam); break;
    case 3: run_phase<3>(p, smem_raw, s_item, lam); break;
    case 4: run_phase<4>(p, smem_raw, s_item, lam); break;
    case 5: run_phase<5>(p, smem_raw, s_item, lam); break;
    case 6: run_phase<6>(p, smem_raw, s_item, lam); break;
    default: run_phase<7>(p, smem_raw, s_item, lam); break;
  }
#endif
}

extern "C" void kernel_launch(void* const* d_in, const int* in_sizes, int n_in, void* d_out, int out_size, void* d_ws,
                              size_t ws_size, hipStream_t stream) {
  static int grid_blocks = 0;
  if (!grid_blocks) {
    int dev = 0, cus = 0;
    (void)hipGetDevice(&dev);
    (void)hipDeviceGetAttribute(&cus, hipDeviceAttributeMultiprocessorCount, dev);
    if (cus <= 0) cus = 256;
    grid_blocks = cus;
  }
  Params p{};
  p.x_prompt = (const float*)d_in[0]; p.x_sample = (const float*)d_in[1]; p.cache_k = (const float*)d_in[2];
  p.cache_v = (const float*)d_in[3]; p.state_gla = (const float*)d_in[4]; p.norm_in_g = (const float*)d_in[5];
  p.w_in = (const float*)d_in[6]; p.w_alpha_up = (const float*)d_in[7]; p.b_alpha = (const float*)d_in[8];
  p.lq1 = (const float*)d_in[9]; p.lk1 = (const float*)d_in[10]; p.lq2 = (const float*)d_in[11]; p.lk2 = (const float*)d_in[12];
  p.da_norm_g = (const float*)d_in[13]; p.gla_norm_g = (const float*)d_in[14]; p.w_branch_a = (const float*)d_in[15];
  p.w_branch_b = (const float*)d_in[16]; p.w_out = (const float*)d_in[17]; p.norm_final_g = (const float*)d_in[18];
  p.out = (float*)d_out; p.ws = (char*)d_ws;
  (void)hipMemsetAsync(d_ws, 0, 65536, stream);
#if MK_ONE_LAUNCH
  p.phase_lo = 0; p.phase_hi = 7;
  void* args[] = {&p};
  hipError_t e = hipLaunchCooperativeKernel((void*)fwd_kernel, dim3(grid_blocks), dim3(NT), args, 0, stream);
  if (e != hipSuccess) fprintf(stderr, "cooperative launch failed: %s (grid %d)\n", hipGetErrorString(e), grid_blocks);
#else
  for (int ph = 0; ph <= 7; ++ph) {
    p.phase_lo = ph; p.phase_hi = ph;
    fwd_kernel<<<dim3(grid_blocks), dim3(NT), 0, stream>>>(p);
  }
#endif
}
```

```cpp
#include <hip/hip_runtime.h>
#include <cstdio>
#include <cstdint>

typedef unsigned short ushort_t;
typedef short bf16x8 __attribute__((ext_vector_type(8)));
typedef float f32x2 __attribute__((ext_vector_type(2)));
typedef float f32x4 __attribute__((ext_vector_type(4)));
typedef float f32x16 __attribute__((ext_vector_type(16)));
typedef unsigned u32x4 __attribute__((ext_vector_type(4)));
typedef unsigned u32x2 __attribute__((ext_vector_type(2)));
typedef __bf16 bf16x2_t __attribute__((ext_vector_type(2)));

#define NT 512
#define TP 16384
#define TS 1024
#define TT 17408
#define DM 1024
#define NPAD 5888
#define EPS 1e-6f
#define QSCALE (0.125f * 1.4426950408889634f)

#define O_YP 0
#define O_YS 16777216
#define O_KP 17825792
#define O_VP 26214400
#define O_GP 34603008
#define O_KS 34668544
#define O_VS 35192832
#define O_GS 35717120

#define WS_CTRL   0ull
#define WS_WTIN   (65536ull)
#define WS_WAT    (WS_WTIN + (size_t)NPAD * 1024 * 2)
#define WS_WBT    (WS_WAT + 1024ull * 512 * 2)
#define WS_WOT    (WS_WBT + 1024ull * 512 * 2)
#define WS_XN     (WS_WOT + 1024ull * 1024 * 2)
#define WS_QA     (WS_XN + (size_t)TT * 1024 * 2)
#define WS_KA     (WS_QA + (size_t)TT * 512 * 2)
#define WS_VTP    (WS_KA + (size_t)TT * 512 * 2)
#define WS_VTS    (WS_VTP + (size_t)TP * 512 * 2)
#define WS_DGS    (WS_VTS + (size_t)TS * 512 * 2)
#define WS_GQK    (WS_DGS + (size_t)TT * 512 * 2)
#define WS_GVTP   (WS_GQK + (size_t)TT * 512 * 2)
#define WS_GVTS   (WS_GVTP + (size_t)TP * 512 * 2)
#define WS_GGS    (WS_GVTS + (size_t)TS * 512 * 2)
#define WS_GAF    (WS_GGS + (size_t)TT * 512 * 2)
#define WS_MGS    (WS_GAF + (size_t)TT * 16 * 4)
#define WS_OAF    (WS_MGS + (size_t)TT * 2048 * 2)
#define WS_OBF    (WS_OAF + (size_t)TT * 512 * 2)
#define WS_GLAT   (WS_OBF + (size_t)TT * 512 * 2)
#define WS_GLAD   (WS_GLAT + 1024ull * 8192 * 4)
#define WS_GLAS   (WS_GLAD + 1024ull * 64 * 4)
#define WS_MIX    (WS_GLAS + 1024ull * 8192 * 2)
#define WS_SSQ    (WS_MIX + (size_t)TT * 1024 * 2)
#define WS_BCUM   (WS_SSQ + (size_t)TT * 16 * 4)
#define WS_END    (WS_BCUM + (size_t)TP * 256 * 4)

struct Params {
  const float *x_prompt, *x_sample, *cache_k, *cache_v, *state_gla, *norm_in_g, *w_in, *w_alpha_up, *b_alpha;
  const float *lq1, *lk1, *lq2, *lk2, *da_norm_g, *gla_norm_g, *w_branch_a, *w_branch_b, *w_out, *norm_final_g;
  float* out;
  char* ws;
  int phase_lo, phase_hi;
};

#ifndef PHASE_MASK
#define PHASE_MASK 0xFF
#endif
#define PH_ON(n) ((PHASE_MASK >> (n)) & 1)
#ifndef P2SUB
#define P2SUB 15
#endif
#ifndef REPEAT_MASK
#define REPEAT_MASK 0
#endif
#define REP_ON(n) ((REPEAT_MASK >> (n)) & 1)
#ifndef MK_ONE_LAUNCH
#define MK_ONE_LAUNCH 1
#endif

__device__ __forceinline__ unsigned pack2(float a, float b) {
  f32x2 v = {a, b};
  bf16x2_t r = __builtin_convertvector(v, bf16x2_t);
  return *(unsigned*)&r;
}
__device__ __forceinline__ ushort_t f2bf(float f) { return (ushort_t)(pack2(f, 0.f) & 0xffffu); }
__device__ __forceinline__ f32x4 mkf4(float a, float b, float c, float d) { f32x4 r = {a, b, c, d}; return r; }
__device__ __forceinline__ float bf2f(ushort_t h) { return __uint_as_float(((unsigned)h) << 16); }
__device__ __forceinline__ float bflo(unsigned u) { return __uint_as_float(u << 16); }
__device__ __forceinline__ float bfhi(unsigned u) { return __uint_as_float(u & 0xffff0000u); }
__device__ __forceinline__ u32x2 pack4(float a, float b, float c, float d) {
  u32x2 r; r.x = pack2(a, b); r.y = pack2(c, d); return r;
}
__device__ __forceinline__ float wave_sum(float v) {
#pragma unroll
  for (int o = 32; o >= 1; o >>= 1) v += __shfl_xor(v, o);
  return v;
}
__device__ __forceinline__ float silu_f(float x) { return x * __builtin_amdgcn_rcpf(1.f + __expf(-x)); }
__device__ __forceinline__ float sigmoid_f(float x) { return 1.f / (1.f + __expf(-x)); }

__device__ __forceinline__ int ltid() { int t = threadIdx.x; asm volatile("" : "+v"(t)); return t; }
__device__ __forceinline__ float xmax32(float x) {
  const unsigned xi = __float_as_uint(x);
  auto r = __builtin_amdgcn_permlane32_swap(xi, xi, false, false);
  return fmaxf(__uint_as_float(r[0]), __uint_as_float(r[1]));
}
__device__ __forceinline__ u32x4 widen16(u32x2 p0, u32x2 p1) {
  auto a = __builtin_amdgcn_permlane16_swap(p0.x, p1.x, false, false);
  auto b = __builtin_amdgcn_permlane16_swap(p0.y, p1.y, false, false);
  return (u32x4){a[0], b[0], a[1], b[1]};
}
#define MFMA32(a, b, c) __builtin_amdgcn_mfma_f32_32x32x16_bf16((a), (b), (c), 0, 0, 0)

#define XB_TMO      128
#define XB_XCNT(j)  (256  + 64 * (j))
#define XB_XSUB(j)  (1280 + 64 * (j))
#define XB_XGEN(j)  (2304 + 64 * (j))
#define XB_TOP      3328
#define XB_TOPGEN   3392
#define XCD_BAR_WORDS 3456
#define XB_SPIN_CAP (1u << 22)
#define LAS __attribute__((address_space(3)))

__device__ __forceinline__ unsigned xb_ld(unsigned* p) { return __hip_atomic_load(p, __ATOMIC_RELAXED, __HIP_MEMORY_SCOPE_AGENT); }
__device__ __forceinline__ unsigned xb_add(unsigned* p, unsigned v) { return __hip_atomic_fetch_add(p, v, __ATOMIC_RELAXED, __HIP_MEMORY_SCOPE_AGENT); }
__device__ __forceinline__ unsigned xb_xcc_id() { return (unsigned)__builtin_amdgcn_s_getreg((3 << 11) | 20) & 0xFu; }
#define XB_SPIN(cond, bar) do { unsigned _sp = 0; while (cond) { __builtin_amdgcn_s_sleep(1); \
    if ((++_sp & 255u) == 0u) { if (xb_ld(&(bar)[XB_TMO])) break; if (_sp > XB_SPIN_CAP) { atomicAdd(&(bar)[XB_TMO], 1u); break; } } } } while (0)

struct XcdBarrier { unsigned* bar; unsigned x; volatile unsigned* st; };

__device__ __forceinline__ XcdBarrier xcd_barrier_post(unsigned* bar, volatile unsigned* st) {
  XcdBarrier b; b.bar = bar; b.x = xb_xcc_id(); b.st = st;
  if (threadIdx.x == 0) (void)xb_add(&bar[XB_XCNT(b.x)], 1u);
  return b;
}
__device__ __forceinline__ void xcd_barrier_complete(unsigned* bar, unsigned x, unsigned& nloc, unsigned& nx) {
  const unsigned G = gridDim.x * gridDim.y * gridDim.z;
  unsigned sum, cnt, mine, sp = 0u;
  for (;;) {
    sum = 0u; cnt = 0u; mine = 0u;
#pragma unroll
    for (unsigned j = 0; j < 16; ++j) { const unsigned c = xb_ld(&bar[XB_XCNT(j)]); sum += c; cnt += (c > 0u) ? 1u : 0u; mine = (j == x) ? c : mine; }
    if (sum == G) break;
    __builtin_amdgcn_s_sleep(1);
    if ((++sp & 255u) == 0u) { if (xb_ld(&bar[XB_TMO])) break; if (sp > XB_SPIN_CAP) { atomicAdd(&bar[XB_TMO], 1u); break; } }
  }
  nloc = mine > 0u ? mine : 1u; nx = cnt > 0u ? cnt : 1u;
}
__device__ __forceinline__ void xcd_barrier(const XcdBarrier& b) {
  asm volatile("s_waitcnt vmcnt(0)" ::: "memory");
  __syncthreads();
  if (threadIdx.x == 0) {
    unsigned* bar = b.bar;
    __builtin_amdgcn_s_waitcnt(0);
    unsigned nloc = b.st[0], nx = b.st[1];
    if (nloc == 0u) { xcd_barrier_complete(bar, b.x, nloc, nx); b.st[0] = nloc; b.st[1] = nx; }
    const unsigned old = xb_add(&bar[XB_XSUB(b.x)], 1u);
    const unsigned gen = old / nloc;
    if (old + 1u == (gen + 1u) * nloc) {
      __builtin_amdgcn_fence(__ATOMIC_RELEASE, "agent");
      asm volatile("s_waitcnt vmcnt(0)" ::: "memory");
      const unsigned og = xb_add(&bar[XB_TOP], 1u);
      const unsigned tg = og / nx;
      if (og + 1u == (tg + 1u) * nx) xb_add(&bar[XB_TOPGEN], 1u);
      else XB_SPIN(xb_ld(&bar[XB_TOPGEN]) == tg, bar);
      __builtin_amdgcn_fence(__ATOMIC_ACQUIRE, "agent");
      xb_add(&bar[XB_XGEN(b.x)], 1u);
      asm volatile("s_waitcnt vmcnt(0)" ::: "memory");
    } else {
      XB_SPIN(xb_ld(&bar[XB_XGEN(b.x)]) == gen, bar);
      __builtin_amdgcn_fence(__ATOMIC_ACQUIRE, "agent");
      asm volatile("s_waitcnt vmcnt(0)" ::: "memory");
    }
  }
  __syncthreads();
}

__device__ __forceinline__ int perm_in(int n) {
  if (n < 3584) return n;
  if (n < 3600) return 5632 + (n - 3584);
  const int c = n - 3600, isB = c >> 10, cc = c & 1023;
  return 3584 + (cc >> 7) * 256 + isB * 128 + (cc & 127);
}

__device__ __forceinline__ void p0_transpose_block(const float* __restrict__ src, int K, int N, int k0, int n0,
                                                   ushort_t* __restrict__ dst, bool permute, float* sT) {
  const int tid = ltid();
  const int c = tid & 255, r0 = tid >> 8;
  float v[32];
  const bool ok = (n0 + c) < N;
#pragma unroll
  for (int i = 0; i < 32; ++i) v[i] = ok ? __builtin_nontemporal_load(&src[(size_t)(k0 + r0 + 2 * i) * N + n0 + c]) : 0.f;
#pragma unroll
  for (int i = 0; i < 32; ++i) sT[(r0 + 2 * i) * 257 + c] = v[i];
  __syncthreads();
  const int kk = tid & 63, nn0 = tid >> 6;
#pragma unroll 8
  for (int i = 0; i < 32; ++i) {
    const int nn = nn0 + 8 * i, n = n0 + nn;
    if (n < N) {
      const int nd = permute ? perm_in(n) : n;
      dst[(size_t)nd * K + k0 + kk] = f2bf(sT[kk * 257 + nn]);
    }
  }
  __syncthreads();
}

__device__ __forceinline__ void phase0(const Params& p, float* smem) {
  const int tid = ltid();
  ushort_t* wtin = (ushort_t*)(p.ws + WS_WTIN);
  ushort_t* wat = (ushort_t*)(p.ws + WS_WAT);
  ushort_t* wbt = (ushort_t*)(p.ws + WS_WBT);
  ushort_t* wot = (ushort_t*)(p.ws + WS_WOT);
  ushort_t* xn = (ushort_t*)(p.ws + WS_XN);
  {
    const int wave = tid >> 6, lane = tid & 63;
    const int ngrp = TT / 4;
    for (int g = blockIdx.x * 8 + wave; g < ngrp; g += gridDim.x * 8) {
      const int row = g * 4;
      const float* xr = (row < TP) ? (p.x_prompt + (size_t)row * DM) : (p.x_sample + (size_t)(row - TP) * DM);
      f32x4 v[4][4];
#pragma unroll
      for (int rr = 0; rr < 4; ++rr)
#pragma unroll
        for (int i = 0; i < 4; ++i) v[rr][i] = __builtin_nontemporal_load(&((const f32x4*)(xr + (size_t)rr * DM))[lane + 64 * i]);
      float rn[4];
#pragma unroll
      for (int rr = 0; rr < 4; ++rr) {
        float ss = 0.f;
#pragma unroll
        for (int i = 0; i < 4; ++i) ss += v[rr][i].x * v[rr][i].x + v[rr][i].y * v[rr][i].y + v[rr][i].z * v[rr][i].z + v[rr][i].w * v[rr][i].w;
        ss = wave_sum(ss);
        rn[rr] = rsqrtf(ss * (1.f / DM) + EPS);
      }
#pragma unroll
      for (int i = 0; i < 4; ++i) {
        const f32x4 g4 = ((const f32x4*)p.norm_in_g)[lane + 64 * i];
#pragma unroll
        for (int rr = 0; rr < 4; ++rr)
          ((u32x2*)(xn + (size_t)(row + rr) * DM))[lane + 64 * i] =
              pack4(v[rr][i].x * rn[rr] * g4.x, v[rr][i].y * rn[rr] * g4.y, v[rr][i].z * rn[rr] * g4.z, v[rr][i].w * rn[rr] * g4.w);
      }
    }
  }
  const int n_in = 16 * 23, n_a = 32, n_b = 32, n_o = 64;
  const int n_tr = n_in + n_a + n_b + n_o;
  for (int it = blockIdx.x; it < n_tr; it += gridDim.x) {
    if (it < n_in) {
      int kt = it / 23, nt = it % 23;
      p0_transpose_block(p.w_in, 1024, 5648, kt * 64, nt * 256, wtin, true, smem);
    } else if (it < n_in + n_a) {
      int j = it - n_in; int kt = j / 4, nt = j % 4;
      p0_transpose_block(p.w_branch_a, 512, 1024, kt * 64, nt * 256, wat, false, smem);
    } else if (it < n_in + n_a + n_b) {
      int j = it - n_in - n_a; int kt = j / 4, nt = j % 4;
      p0_transpose_block(p.w_branch_b, 512, 1024, kt * 64, nt * 256, wbt, false, smem);
    } else {
      int j = it - n_in - n_a - n_b; int kt = j / 4, nt = j % 4;
      p0_transpose_block(p.w_out, 1024, 1024, kt * 64, nt * 256, wot, false, smem);
    }
  }
}

#define G_BK 64
#define G_HALF 128
#define G_HT (G_HALF * G_BK)

__device__ __forceinline__ int lds_byte(int r, int c) {
  int st = (r >> 4) * 2 + (c >> 5), rr = r & 15, cc = c & 31, ob = rr * 64 + cc * 2;
  return st * 1024 + (ob ^ (((ob >> 9) & 1) << 5));
}
__device__ __forceinline__ void stage_rc(int b, int& R, int& C) {
  int st = b / 1024, sb = b % 1024, swz = sb ^ (((sb >> 9) & 1) << 5);
  R = (st >> 1) * 16 + swz / 64; C = (st & 1) * 32 + (swz % 64) / 2;
}

#define SA(b, h) (shm + ((b) * 2 + (h)) * G_HT)
#define SB(b, h) (shm + (4 + (b) * 2 + (h)) * G_HT)
#define STAGE(P, BASE, br, kt) do { const char* _ub = (const char*)((BASE) + (long)(br) * K + (long)(kt) * G_BK); \
    _Pragma("unroll") for (int _i = 0; _i < 2; ++_i) { \
      __builtin_amdgcn_global_load_lds((const unsigned*)(_ub + (size_t)so_b[_i]), \
        (LAS unsigned*)((LAS char*)(P) + tl * 16 + _i * 8192), 16, 0, 0); } } while (0)
#define LDA(dst, b, h) for (int m = 0; m < 4; ++m) for (int k = 0; k < 2; ++k) \
    dst[m][k] = *reinterpret_cast<const LAS bf16x8*>((const LAS char*)SA(b, h) + lds_byte(wr * 64 + m * 16 + fr, k * 32 + fq * 8))
#define LDB(dst, b, h) for (int n = 0; n < 2; ++n) for (int k = 0; k < 2; ++k) \
    dst[n][k] = *reinterpret_cast<const LAS bf16x8*>((const LAS char*)SB(b, h) + lds_byte(wc * 32 + n * 16 + fr, k * 32 + fq * 8))
#define MMA(ai, bj, At, Bt_) do { __builtin_amdgcn_s_setprio(1); \
    for (int m = 0; m < 4; ++m) for (int n = 0; n < 2; ++n) for (int k = 0; k < 2; ++k) \
      acc[ai][bj][m][n] = __builtin_amdgcn_mfma_f32_16x16x32_bf16(At[m][k], Bt_[n][k], acc[ai][bj][m][n], 0, 0, 0); \
    __builtin_amdgcn_s_setprio(0); } while (0)
#define WAIT_V(n) asm volatile("s_waitcnt vmcnt(" #n ")" ::: "memory")
#define WAIT_L(n) asm volatile("s_waitcnt lgkmcnt(" #n ")" ::: "memory")
#define BAR __builtin_amdgcn_s_barrier()
#define SCHED __builtin_amdgcn_sched_barrier(0)

template <bool ZERO = true>
__device__ __forceinline__ void gemm256(const ushort_t* __restrict__ A, const ushort_t* __restrict__ Bt, const int K,
                                        LAS ushort_t* shm, f32x4 (&acc)[2][2][4][2]) {
  int tl = threadIdx.x; asm volatile("" : "+v"(tl));
  const int wid = tl >> 6, lane = tl & 63, wr = wid >> 2, wc = wid & 3, fr = lane & 15, fq = lane >> 4;
  const int brow = 0, bcol = 0;
  unsigned so_b[2];
#pragma unroll
  for (int i = 0; i < 2; ++i) { int r_, c_; stage_rc(tl * 16 + i * 8192, r_, c_); so_b[i] = (unsigned)((r_ * K + c_) * 2); }
  bf16x8 At[4][2], B0[2][2], B1[2][2];
  const int nt = K / G_BK;
  if (ZERO) {
#pragma unroll
    for (int a = 0; a < 2; ++a)
#pragma unroll
      for (int b = 0; b < 2; ++b)
#pragma unroll
        for (int m = 0; m < 4; ++m)
#pragma unroll
          for (int n = 0; n < 2; ++n) acc[a][b][m][n] = (f32x4){0.f, 0.f, 0.f, 0.f};
  }
  STAGE(SB(0, 0), Bt, bcol, 0); STAGE(SA(0, 0), A, brow, 0);
  STAGE(SB(0, 1), Bt, bcol + G_HALF, 0); STAGE(SA(0, 1), A, brow + G_HALF, 0);
  if (wr == 1) BAR;
  WAIT_V(4); BAR;
  STAGE(SB(1, 0), Bt, bcol, 1); STAGE(SA(1, 0), A, brow, 1); STAGE(SB(1, 1), Bt, bcol + G_HALF, 1);
  WAIT_V(6); BAR;
  for (int t = 0; t < nt - 2; t += 2) {
    LDB(B0, 0, 0); SCHED; LDA(At, 0, 0); STAGE(SA(1, 1), A, brow + G_HALF, t + 1);
    WAIT_L(8); BAR; WAIT_L(0); MMA(0, 0, At, B0); BAR; SCHED;
    LDB(B1, 0, 1); STAGE(SB(0, 0), Bt, bcol, t + 2);
    BAR; WAIT_L(0); MMA(0, 1, At, B1); BAR;
    LDA(At, 0, 1); STAGE(SA(0, 0), A, brow, t + 2);
    BAR; WAIT_L(0); MMA(1, 0, At, B0); BAR; SCHED;
    STAGE(SB(0, 1), Bt, bcol + G_HALF, t + 2);
    WAIT_V(6); BAR; MMA(1, 1, At, B1); BAR;
    LDB(B0, 1, 0); SCHED; LDA(At, 1, 0); STAGE(SA(0, 1), A, brow + G_HALF, t + 2);
    WAIT_L(8); BAR; WAIT_L(0); MMA(0, 0, At, B0); BAR; SCHED;
    LDB(B1, 1, 1); STAGE(SB(1, 0), Bt, bcol, t + 3);
    BAR; WAIT_L(0); MMA(0, 1, At, B1); BAR;
    LDA(At, 1, 1); STAGE(SA(1, 0), A, brow, t + 3);
    BAR; WAIT_L(0); MMA(1, 0, At, B0); BAR; SCHED;
    STAGE(SB(1, 1), Bt, bcol + G_HALF, t + 3);
    WAIT_V(6); BAR; MMA(1, 1, At, B1); BAR;
  }
  { LDB(B0, 0, 0); LDA(At, 0, 0); STAGE(SA(1, 1), A, brow + G_HALF, nt - 1);
    BAR; WAIT_L(0); MMA(0, 0, At, B0); BAR;
    LDB(B1, 0, 1); BAR; WAIT_L(0); MMA(0, 1, At, B1); BAR;
    LDA(At, 0, 1); WAIT_V(4); BAR; WAIT_L(0); MMA(1, 0, At, B0); MMA(1, 1, At, B1); BAR; }
  { LDB(B0, 1, 0); LDA(At, 1, 0); WAIT_V(2); BAR; WAIT_L(0); MMA(0, 0, At, B0); BAR;
    LDB(B1, 1, 1); WAIT_V(0); BAR; WAIT_L(0); MMA(0, 1, At, B1); BAR;
    LDA(At, 1, 1); BAR; WAIT_L(0); MMA(1, 0, At, B0); MMA(1, 1, At, B1); BAR; }
  if (wr == 0) BAR;
}

#define LAUNDER_IDX() int tl_ = threadIdx.x; asm volatile("" : "+v"(tl_)); \
  const int wid = tl_ >> 6, lane = tl_ & 63, wr = wid >> 2, wc = wid & 3, fr = lane & 15, fq = lane >> 4; (void)lane;
#define ACC_FOREACH_PAIR(...) { LAUNDER_IDX() \
  _Pragma("unroll") for (int ai = 0; ai < 2; ++ai) _Pragma("unroll") for (int bj = 0; bj < 2; ++bj) \
  _Pragma("unroll") for (int m = 0; m < 4; ++m) { \
    const int R = ai * 128 + wr * 64 + m * 16 + fq * 4; const int Cb = bj * 128 + wc * 32 + fr; \
    const int Rw = ai * 128 + wr * 64 + m * 16 + (fq >> 1) * 8; const int Tw = bj * 128 + wc * 32 + (fq & 1) * 16 + fr; \
    (void)R; (void)Cb; (void)Rw; (void)Tw; \
    f32x4& v0 = acc[ai][bj][m][0]; f32x4& v1 = acc[ai][bj][m][1]; __VA_ARGS__ } }
#define ACC_FOREACH(...) { LAUNDER_IDX() \
  _Pragma("unroll") for (int ai = 0; ai < 2; ++ai) _Pragma("unroll") for (int bj = 0; bj < 2; ++bj) \
  _Pragma("unroll") for (int m = 0; m < 4; ++m) _Pragma("unroll") for (int n = 0; n < 2; ++n) { \
    const int R = ai * 128 + wr * 64 + m * 16 + fq * 4; const int Cc = bj * 128 + wc * 32 + n * 16 + fr; \
    f32x4& v = acc[ai][bj][m][n]; __VA_ARGS__ } }

__device__ __forceinline__ void tile_map(int L, int nM, int nN, int& pm, int& pn) {
  const int nwg = nM * nN, q = nwg / 8, r = nwg % 8, xcd = L % 8, off = L / 8;
  const int wgid = (xcd < r ? xcd * (q + 1) : r * (q + 1) + (xcd - r) * q) + off;
  const int nig = 8 * nN, gid = wgid / nig, fm = gid * 8, gsz = (nM - fm) < 8 ? (nM - fm) : 8;
  pm = fm + ((wgid % nig) % gsz); pn = (wgid % nig) / gsz;
}

__device__ __forceinline__ void phase1(const Params& p, LAS ushort_t* shm) {
  const ushort_t* xn = (const ushort_t*)(p.ws + WS_XN);
  const ushort_t* wtin = (const ushort_t*)(p.ws + WS_WTIN);
  ushort_t* qA = (ushort_t*)(p.ws + WS_QA);
  ushort_t* kA = (ushort_t*)(p.ws + WS_KA);
  ushort_t* vtp = (ushort_t*)(p.ws + WS_VTP);
  ushort_t* vts = (ushort_t*)(p.ws + WS_VTS);
  ushort_t* dgs = (ushort_t*)(p.ws + WS_DGS);
  ushort_t* gqk = (ushort_t*)(p.ws + WS_GQK);
  ushort_t* gvtp = (ushort_t*)(p.ws + WS_GVTP);
  ushort_t* gvts = (ushort_t*)(p.ws + WS_GVTS);
  ushort_t* ggs = (ushort_t*)(p.ws + WS_GGS);
  float* gaf = (float*)(p.ws + WS_GAF);
  ushort_t* mgs = (ushort_t*)(p.ws + WS_MGS);
  const int NTN = 22;
  const int NTM = TT / 256;
  for (int it = blockIdx.x; it < NTN * NTM; it += gridDim.x) {
    int nt, mt; tile_map(it, NTM, NTN, mt, nt);
    const int n0 = nt * 256, t0 = mt * 256;
    const bool isS = t0 >= TP;
    f32x4 acc[2][2][4][2];
    const bool vseg = (nt == 4 || nt == 5 || nt == 10 || nt == 11);
    if (vseg) gemm256(xn + (size_t)t0 * DM, wtin + (size_t)n0 * DM, DM, shm, acc);
    else gemm256(wtin + (size_t)n0 * DM, xn + (size_t)t0 * DM, DM, shm, acc);

    if (vseg) {
      const bool isDv = nt < 6;
      const int nb = isDv ? 1024 : 2560;
      ACC_FOREACH_PAIR({
        const int t = t0 + R;
        if (isDv) {
          const int nv = n0 - nb + Cb;
          float* o = isS ? (p.out + O_VS + (size_t)(t - TP) * 512 + nv) : (p.out + O_VP + (size_t)t * 512 + nv);
          __builtin_nontemporal_store(v0[0], o); __builtin_nontemporal_store(v0[1], o + 512);
          __builtin_nontemporal_store(v0[2], o + 1024); __builtin_nontemporal_store(v0[3], o + 1536);
          __builtin_nontemporal_store(v1[0], o + 16); __builtin_nontemporal_store(v1[1], o + 528);
          __builtin_nontemporal_store(v1[2], o + 1040); __builtin_nontemporal_store(v1[3], o + 1552);
        }
        const u32x4 pk = widen16(pack4(v0[0], v0[1], v0[2], v0[3]), pack4(v1[0], v1[1], v1[2], v1[3]));
        const int nvw = n0 - nb + Tw;
        const int hh = nvw >> 7, dv = nvw & 127;
        const int tw = t0 + Rw;
        if (!isS) {
          const int b = tw >> 13, tt = tw & 8191;
          ushort_t* dst = (isDv ? vtp : gvtp) + ((size_t)((b * 4 + hh) * 128 + dv)) * 8192 + tt;
          *(u32x4*)dst = pk;
        } else {
          const int ts = tw - TP; const int b = ts >> 5, tt = ts & 31;
          ushort_t* dst = (isDv ? vts : gvts) + ((size_t)((b * 4 + hh) * 128 + dv)) * 32 + tt;
          *(u32x4*)dst = pk;
        }
      })
    } else {
      if (nt < 14) {
        ACC_FOREACH_PAIR({
          u32x2 p0, p1;
          ushort_t* dst;
          if (nt < 2) {
            p0 = pack4(v0[0] * QSCALE, v0[1] * QSCALE, v0[2] * QSCALE, v0[3] * QSCALE);
            p1 = pack4(v1[0] * QSCALE, v1[1] * QSCALE, v1[2] * QSCALE, v1[3] * QSCALE);
            dst = qA + (size_t)(t0 + Tw) * 512 + n0 + Rw;
          } else if (nt < 4) {
            const int nk = n0 + R - 512;
            const int ta = t0 + Cb, tb = t0 + Cb + 16;
            float* oa_ = isS ? (p.out + O_KS + (size_t)(ta - TP) * 512 + nk) : (p.out + O_KP + (size_t)ta * 512 + nk);
            float* ob_ = isS ? (p.out + O_KS + (size_t)(tb - TP) * 512 + nk) : (p.out + O_KP + (size_t)tb * 512 + nk);
            __builtin_nontemporal_store(v0, (f32x4*)oa_); __builtin_nontemporal_store(v1, (f32x4*)ob_);
            p0 = pack4(v0[0], v0[1], v0[2], v0[3]);
            p1 = pack4(v1[0], v1[1], v1[2], v1[3]);
            dst = kA + (size_t)(t0 + Tw) * 512 + n0 + Rw - 512;
          } else if (nt < 8) {
            p0 = pack4(silu_f(v0[0]), silu_f(v0[1]), silu_f(v0[2]), silu_f(v0[3]));
            p1 = pack4(silu_f(v1[0]), silu_f(v1[1]), silu_f(v1[2]), silu_f(v1[3]));
            dst = dgs + (size_t)(t0 + Tw) * 512 + n0 + Rw - 1536;
          } else if (nt < 10) {
            const float sc = (nt == 8) ? 0.125f : 1.f;
            p0 = pack4(v0[0] * sc, v0[1] * sc, v0[2] * sc, v0[3] * sc);
            p1 = pack4(v1[0] * sc, v1[1] * sc, v1[2] * sc, v1[3] * sc);
            dst = gqk + (size_t)(t0 + Tw) * 512 + n0 + Rw - 2048;
          } else {
            p0 = pack4(silu_f(v0[0]), silu_f(v0[1]), silu_f(v0[2]), silu_f(v0[3]));
            p1 = pack4(silu_f(v1[0]), silu_f(v1[1]), silu_f(v1[2]), silu_f(v1[3]));
            dst = ggs + (size_t)(t0 + Tw) * 512 + n0 + Rw - 3072;
          }
          *(u32x4*)dst = widen16(p0, p1);
        })
      }
      if (nt >= 14 && nt < 22) {
        LAUNDER_IDX()
#pragma unroll
        for (int bj = 0; bj < 2; ++bj)
#pragma unroll
          for (int m = 0; m < 4; ++m) {
            u32x2 prt[2], pgb[2];
#pragma unroll
            for (int n = 0; n < 2; ++n) {
              const f32x4 va = acc[0][bj][m][n], vb = acc[1][bj][m][n];
              float rt[4], gb[4];
#pragma unroll
              for (int j = 0; j < 4; ++j) {
                const float ea = 1.f + __expf(-va[j]), eb = 1.f + __expf(-vb[j]);
                gb[j] = __builtin_amdgcn_rcpf(eb);
                rt[j] = eb * __builtin_amdgcn_rcpf(ea);
              }
              prt[n] = pack4(rt[0], rt[1], rt[2], rt[3]);
              pgb[n] = pack4(gb[0], gb[1], gb[2], gb[3]);
            }
            const int tw = t0 + bj * 128 + wc * 32 + (fq & 1) * 16 + fr;
            const int ccw = (nt - 14) * 128 + wr * 64 + m * 16 + (fq >> 1) * 8;
            *(u32x4*)(mgs + (size_t)tw * 2048 + ccw) = widen16(prt[0], prt[1]);
            *(u32x4*)(mgs + (size_t)tw * 2048 + 1024 + ccw) = widen16(pgb[0], pgb[1]);
          }
      }
    }
  }
  {
    const int G = gridDim.x;
    const int first = (NTN * NTM) % G;
    const int nb = (first == 0) ? G : (G - first);
    const int me = (int)blockIdx.x - ((first == 0) ? 0 : first);
    if (me >= 0) {
      const int tl = ltid();
      const int wv = tl >> 6, ln = tl & 63, fr = ln & 15, fq = ln >> 4;
      for (int j = me; j < NTM; j += nb) {
        const int t0 = j * 256 + wv * 32;
        const ushort_t* ap = wtin + (size_t)(5632 + fr) * DM + fq * 8;
        const ushort_t* bp0 = xn + (size_t)(t0 + fr) * DM + fq * 8;
        const ushort_t* bp1 = bp0 + (size_t)16 * DM;
        f32x4 c0 = {0.f, 0.f, 0.f, 0.f}, c1 = {0.f, 0.f, 0.f, 0.f};
#pragma unroll 1
        for (int kb = 0; kb < 32; kb += 8) {
          bf16x8 af[8], b0[8], b1[8];
#pragma unroll
          for (int u = 0; u < 8; ++u) {
            af[u] = *(const bf16x8*)(ap + (kb + u) * 32);
            b0[u] = *(const bf16x8*)(bp0 + (kb + u) * 32);
            b1[u] = *(const bf16x8*)(bp1 + (kb + u) * 32);
          }
#pragma unroll
          for (int u = 0; u < 8; ++u) {
            c0 = __builtin_amdgcn_mfma_f32_16x16x32_bf16(af[u], b0[u], c0, 0, 0, 0);
            c1 = __builtin_amdgcn_mfma_f32_16x16x32_bf16(af[u], b1[u], c1, 0, 0, 0);
          }
        }
        *(f32x4*)(gaf + (size_t)(t0 + fr) * 16 + fq * 4) = c0;
        *(f32x4*)(gaf + (size_t)(t0 + 16 + fr) * 16 + fq * 4) = c1;
      }
    }
  }
}

#define RESCALE_THR 8.0f
#define KLD 136
#define VLD 72
#define ABUF (64 * KLD + 128 * VLD)

__device__ __forceinline__ void attn_compute_tile(const ushort_t* sK, const ushort_t* sVT, int map, int nu, const bf16x8 (&qf)[4],
                                                  f32x16 (&O)[4], f32x16& Mi, bool first, float& l, int lane) {
  const int r = lane & 31, hh = lane >> 5;
  f32x16 S0, S1;
#pragma unroll
  for (int i = 0; i < 16; ++i) S1[i] = 0.f;
  const ushort_t* kp = sK + r * KLD + map * 64 + 8 * hh;
  const ushort_t* vp = sVT + r * VLD + 8 * hh;
  bf16x8 kf0[4], kf1[4];
#pragma unroll
  for (int s = 0; s < 4; ++s) kf0[s] = *(const bf16x8*)(kp + 16 * s);
  if (nu > 1) {
#pragma unroll
    for (int s = 0; s < 4; ++s) kf1[s] = *(const bf16x8*)(kp + 32 * KLD + 16 * s);
  }
  S0 = MFMA32(kf0[0], qf[0], Mi);
  if (nu > 1) S1 = MFMA32(kf1[0], qf[0], Mi);
#pragma unroll
  for (int s = 1; s < 4; ++s) {
    S0 = MFMA32(kf0[s], qf[s], S0);
    if (nu > 1) S1 = MFMA32(kf1[s], qf[s], S1);
  }
  bf16x8 vf0[2][4];
#pragma unroll
  for (int s2 = 0; s2 < 2; ++s2)
#pragma unroll
    for (int w4 = 0; w4 < 4; ++w4) vf0[s2][w4] = *(const bf16x8*)(vp + 32 * w4 * VLD + 16 * s2);
  float mx = S0[0];
#pragma unroll
  for (int i = 1; i < 16; ++i) mx = fmaxf(mx, S0[i]);
  if (nu > 1) {
#pragma unroll
    for (int i = 0; i < 16; ++i) mx = fmaxf(mx, S1[i]);
  }
  mx = xmax32(mx);
  if (first || __any(mx > RESCALE_THR)) {
    const float d = first ? mx : fmaxf(mx, 0.f);
    if (!first) {
      const float alpha = __builtin_amdgcn_exp2f(-d);
      l *= alpha;
#pragma unroll
      for (int w4 = 0; w4 < 4; ++w4)
#pragma unroll
        for (int i = 0; i < 16; ++i) O[w4][i] *= alpha;
    }
#pragma unroll
    for (int i = 0; i < 16; ++i) { S0[i] -= d; Mi[i] -= d; }
    if (nu > 1) {
#pragma unroll
      for (int i = 0; i < 16; ++i) S1[i] -= d;
    }
  }
  float ps = 0.f;
#pragma unroll
  for (int i = 0; i < 16; ++i) { S0[i] = __builtin_amdgcn_exp2f(S0[i]); ps += S0[i]; }
  if (nu > 1) {
#pragma unroll
    for (int i = 0; i < 16; ++i) { S1[i] = __builtin_amdgcn_exp2f(S1[i]); ps += S1[i]; }
  }
  l += ps;
  bf16x8 vf1[2][4];
  if (nu > 1) {
#pragma unroll
    for (int s2 = 0; s2 < 2; ++s2)
#pragma unroll
      for (int w4 = 0; w4 < 4; ++w4) vf1[s2][w4] = *(const bf16x8*)(vp + 32 * w4 * VLD + 32 + 16 * s2);
  }
#pragma unroll
  for (int s2 = 0; s2 < 2; ++s2) {
    union { bf16x8 v; unsigned u[4]; } pb;
#pragma unroll
    for (int j = 0; j < 4; ++j) pb.u[j] = pack2(S0[8 * s2 + 2 * j], S0[8 * s2 + 2 * j + 1]);
#pragma unroll
    for (int w4 = 0; w4 < 4; ++w4) O[w4] = MFMA32(vf0[s2][w4], pb.v, O[w4]);
  }
  if (nu > 1) {
#pragma unroll
    for (int s2 = 0; s2 < 2; ++s2) {
      union { bf16x8 v; unsigned u[4]; } pb;
#pragma unroll
      for (int j = 0; j < 4; ++j) pb.u[j] = pack2(S1[8 * s2 + 2 * j], S1[8 * s2 + 2 * j + 1]);
#pragma unroll
      for (int w4 = 0; w4 < 4; ++w4) O[w4] = MFMA32(vf1[s2][w4], pb.v, O[w4]);
    }
  }
}

__device__ __forceinline__ int vpos(int key) { return (key & 0x30) | ((key & 4) << 1) | ((key & 8) >> 1) | (key & 3); }

__device__ __forceinline__ void attn_item(const Params& p, ushort_t* smem, int kind, int b, int h, int qp, float lam) {
  int tid_l = threadIdx.x; asm volatile("" : "+v"(tid_l));
  const int tid = tid_l, lane = tid & 63, w = tid >> 6;
  const int map = w & 1, rg = w >> 1;
  const int r = lane & 31, hh = lane >> 5;
  const ushort_t* qA = (const ushort_t*)(p.ws + WS_QA);
  const ushort_t* kA = (const ushort_t*)(p.ws + WS_KA);
  const ushort_t* vtp = (const ushort_t*)(p.ws + WS_VTP);
  const ushort_t* vts = (const ushort_t*)(p.ws + WS_VTS);
  const ushort_t* dgs = (const ushort_t*)(p.ws + WS_DGS);
  ushort_t* oaf = (ushort_t*)(p.ws + WS_OAF);
  const bool active = (kind == 0) || (rg == 0);
  const int qtok0 = (kind == 0) ? (b * 8192 + qp * 128) : (TP + b * 32);
  const int ntiles = (kind == 0) ? (2 * qp + 2) : 33;
  const int mytiles = (kind == 0) ? (2 * qp + 1 + (rg >> 1)) : 33;

  bf16x8 qf[4];
  {
    const int tok = qtok0 + (active ? rg : 0) * 32 + r;
#pragma unroll
    for (int s = 0; s < 4; ++s) qf[s] = *(const bf16x8*)(qA + (size_t)tok * 512 + h * 128 + map * 64 + 16 * s + 8 * hh);
  }
  f32x16 O[4];
#pragma unroll
  for (int w4 = 0; w4 < 4; ++w4)
#pragma unroll
    for (int i = 0; i < 16; ++i) O[w4][i] = 0.f;
  float l = 0.f;
  f32x16 Mi;
#pragma unroll
  for (int i = 0; i < 16; ++i) Mi[i] = 0.f;

  __syncthreads();
  if (kind == 0) {
    const size_t kbase = ((size_t)b * 8192) * 512 + h * 128;
    const size_t vbase = ((size_t)(b * 4 + h) * 128) * 8192;
    const int id0 = tid, id1 = tid + 512;
    const int kso0 = (id0 >> 4) * KLD + (id0 & 15) * 8, kso1 = (id1 >> 4) * KLD + (id1 & 15) * 8;
    const int vso0 = 64 * KLD + (id0 >> 3) * VLD + ((id0 & 6) << 3) + ((id0 & 1) << 2);
    const int vso1 = 64 * KLD + (id1 >> 3) * VLD + ((id1 & 6) << 3) + ((id1 & 1) << 2);
    const ushort_t* kg0 = kA + kbase + (size_t)(id0 >> 4) * 512 + (id0 & 15) * 8;
    const ushort_t* kg1 = kA + kbase + (size_t)(id1 >> 4) * 512 + (id1 & 15) * 8;
    const ushort_t* vg0 = vtp + vbase + (size_t)(id0 >> 3) * 8192 + (id0 & 7) * 8;
    const ushort_t* vg1 = vtp + vbase + (size_t)(id1 >> 3) * 8192 + (id1 & 7) * 8;
    u32x4 kr0, kr1, vr0, vr1;
#define ATT_LOAD(T) do { kr0 = *(const u32x4*)(kg0 + (size_t)(T) * 64 * 512); kr1 = *(const u32x4*)(kg1 + (size_t)(T) * 64 * 512); \
                         vr0 = *(const u32x4*)(vg0 + (T) * 64); vr1 = *(const u32x4*)(vg1 + (T) * 64); } while (0)
#define ATT_STORE(BUF) do { ushort_t* _d = (BUF); *(u32x4*)(_d + kso0) = kr0; *(u32x4*)(_d + kso1) = kr1; \
                            *(u32x2*)(_d + vso0) = (u32x2){vr0.x, vr0.y}; *(u32x2*)(_d + vso0 + 8) = (u32x2){vr0.z, vr0.w}; \
                            *(u32x2*)(_d + vso1) = (u32x2){vr1.x, vr1.y}; *(u32x2*)(_d + vso1 + 8) = (u32x2){vr1.z, vr1.w}; } while (0)
    ATT_LOAD(0); ATT_STORE(smem);
    ATT_LOAD(1); ATT_STORE(smem + ABUF);
    __syncthreads();
    const int npairs = qp + 1;
    for (int i = 0; i < npairs; ++i) {
      ushort_t* cur = smem + (i & 1) * 2 * ABUF;
      ushort_t* nxt = smem + ((i + 1) & 1) * 2 * ABUF;
      const bool more = (i + 1 < npairs);
      if (more) ATT_LOAD(2 * i + 2);
      if (2 * i < mytiles) attn_compute_tile(cur, cur + 64 * KLD, map, 2, qf, O, Mi, i == 0, l, lane);
      if (more) { ATT_STORE(nxt); ATT_LOAD(2 * i + 3); }
      if (2 * i + 1 < mytiles) attn_compute_tile(cur + ABUF, cur + ABUF + 64 * KLD, map, 2, qf, O, Mi, false, l, lane);
      if (more) ATT_STORE(nxt + ABUF);
      __syncthreads();
    }
#undef ATT_LOAD
#undef ATT_STORE
  } else {
    f32x4 kr[4], vr[4];
    {
      const float* ck = p.cache_k + ((size_t)(b * 2048) * 4 + h) * 128;
      const float* cv = p.cache_v + ((size_t)(b * 2048) * 4 + h) * 128;
#pragma unroll
      for (int i = 0; i < 4; ++i) {
        const int id = tid + 512 * i;
        kr[i] = __builtin_nontemporal_load((const f32x4*)(ck + (size_t)(id >> 5) * 512 + (id & 31) * 4));
      }
#pragma unroll
      for (int i = 0; i < 2; ++i) {
        const int id = tid + 512 * i;
        vr[2 * i] = __builtin_nontemporal_load((const f32x4*)(cv + (size_t)(2 * (id >> 5)) * 512 + (id & 31) * 4));
        vr[2 * i + 1] = __builtin_nontemporal_load((const f32x4*)(cv + (size_t)(2 * (id >> 5) + 1) * 512 + (id & 31) * 4));
      }
    }
    for (int t = 0; t < 33; ++t) {
      ushort_t* cb = smem + (t & 1) * ABUF;
      if (t < 32) {
#pragma unroll
        for (int i = 0; i < 4; ++i) {
          const int id = tid + 512 * i;
          *(u32x2*)(cb + (id >> 5) * KLD + (id & 31) * 4) = pack4(kr[i].x, kr[i].y, kr[i].z, kr[i].w);
        }
#pragma unroll
        for (int i = 0; i < 2; ++i) {
          const int id = tid + 512 * i;
          const int key = 2 * (id >> 5), dv = (id & 31) * 4;
          ushort_t* vd = cb + 64 * KLD + dv * VLD + vpos(key);
          const f32x4 va = vr[2 * i], vb = vr[2 * i + 1];
          *(unsigned*)vd = pack2(va.x, vb.x); *(unsigned*)(vd + VLD) = pack2(va.y, vb.y);
          *(unsigned*)(vd + 2 * VLD) = pack2(va.z, vb.z); *(unsigned*)(vd + 3 * VLD) = pack2(va.w, vb.w);
        }
      } else {
        const int id = tid;
        u32x4 kv = *(const u32x4*)(kA + (size_t)(TP + b * 32 + (id >> 4)) * 512 + h * 128 + (id & 15) * 8);
        *(u32x4*)(cb + (id >> 4) * KLD + (id & 15) * 8) = kv;
        u32x4 vv = *(const u32x4*)(vts + ((size_t)(b * 4 + h) * 128 + (id >> 2)) * 32 + (id & 3) * 8);
        ushort_t* vd = cb + 64 * KLD + (id >> 2) * VLD + ((id & 2) << 3) + ((id & 1) << 2);
        *(u32x2*)vd = (u32x2){vv.x, vv.y};
        *(u32x2*)(vd + 8) = (u32x2){vv.z, vv.w};
      }
      if (t + 1 < 32) {
        const float* ck = p.cache_k + ((size_t)(b * 2048 + (t + 1) * 64) * 4 + h) * 128;
        const float* cv = p.cache_v + ((size_t)(b * 2048 + (t + 1) * 64) * 4 + h) * 128;
#pragma unroll
        for (int i = 0; i < 4; ++i) {
          const int id = tid + 512 * i;
          kr[i] = __builtin_nontemporal_load((const f32x4*)(ck + (size_t)(id >> 5) * 512 + (id & 31) * 4));
        }
#pragma unroll
        for (int i = 0; i < 2; ++i) {
          const int id = tid + 512 * i;
          vr[2 * i] = __builtin_nontemporal_load((const f32x4*)(cv + (size_t)(2 * (id >> 5)) * 512 + (id & 31) * 4));
          vr[2 * i + 1] = __builtin_nontemporal_load((const f32x4*)(cv + (size_t)(2 * (id >> 5) + 1) * 512 + (id & 31) * 4));
        }
      }
      __syncthreads();
      if (active) attn_compute_tile(cb, cb + 64 * KLD, map, (t < 32) ? 2 : 1, qf, O, Mi, t == 0, l, lane);
    }
    __syncthreads();
  }

  {
    float a = p.lq1[lane] * p.lk1[lane];
    float bq = p.lq2[lane] * p.lk2[lane];
    a = wave_sum(a); bq = wave_sum(bq);
    lam = __expf(a) - __expf(bq) + 0.2f;
  }
  l += __shfl_xor(l, 32);
  const float inv = 1.f / l;
  float* sEx = (float*)smem;
  if (active && map == 1) {
#pragma unroll
    for (int w4 = 0; w4 < 4; ++w4)
#pragma unroll
      for (int i = 0; i < 16; ++i) {
        const int dv = 32 * w4 + (i & 3) + 8 * (i >> 2) + 4 * hh;
        sEx[(rg * 128 + dv) * 32 + r] = O[w4][i] * inv;
      }
  }
  __syncthreads();
  if (active && map == 0) {
    float ssq = 0.f;
#pragma unroll
    for (int w4 = 0; w4 < 4; ++w4)
#pragma unroll
      for (int i = 0; i < 16; ++i) {
        const int dv = 32 * w4 + (i & 3) + 8 * (i >> 2) + 4 * hh;
        const float o = O[w4][i] * inv - lam * sEx[(rg * 128 + dv) * 32 + r];
        O[w4][i] = o;
        ssq += o * o;
      }
    ssq += __shfl_xor(ssq, 32);
    const float rn = rsqrtf(ssq * (1.f / 128.f) + EPS) * 0.8f;
    const int tok = qtok0 + rg * 32 + r;
#pragma unroll
    for (int w4 = 0; w4 < 4; ++w4)
#pragma unroll
      for (int i4 = 0; i4 < 4; ++i4) {
        const int dv0 = 32 * w4 + 8 * i4 + 4 * hh;
        const f32x4 g = *(const f32x4*)(p.da_norm_g + dv0);
        const u32x2 sg = *(const u32x2*)(dgs + (size_t)tok * 512 + h * 128 + dv0);
        *(u32x2*)(oaf + (size_t)tok * 512 + h * 128 + dv0) =
            pack4(O[w4][4 * i4] * rn * g.x * bflo(sg.x), O[w4][4 * i4 + 1] * rn * g.y * bfhi(sg.x),
                  O[w4][4 * i4 + 2] * rn * g.z * bflo(sg.y), O[w4][4 * i4 + 3] * rn * g.w * bfhi(sg.y));
      }
  }
  __syncthreads();
}

#define GLD 72
#define GLA_PREP_FLOATS (1024 + 1024 + 512 + 64)
__device__ __forceinline__ void gla_prep(const Params& p, float* sp, int tok0, int C, int h, float (&bv)[8], float& blast) {
  const int tid = ltid();
  const int k = tid & 63, sq = tid >> 6;
  const float* gaf = (const float*)(p.ws + WS_GAF);
  float* sGa = sp; float* sWu = sp + 1024; float* sSeg = sp + 2048;
  __syncthreads();
  if (tid < 256) {
    const int t = tid >> 2;
    f32x4 v = (t < C) ? *(const f32x4*)(gaf + (size_t)(tok0 + t) * 16 + (tid & 3) * 4) : mkf4(0.f, 0.f, 0.f, 0.f);
    *(f32x4*)(sGa + t * 16 + (tid & 3) * 4) = v;
  }
#pragma unroll
  for (int i = 0; i < 2; ++i) {
    const int id = tid + 512 * i;
    sWu[id] = p.w_alpha_up[(id >> 6) * 256 + h * 64 + (id & 63)];
  }
  __syncthreads();
  const float ba = p.b_alpha[h * 64 + k];
  float wu[16];
#pragma unroll
  for (int rr = 0; rr < 16; ++rr) wu[rr] = sWu[rr * 64 + k];
  float run = 0.f;
#pragma unroll
  for (int e = 0; e < 8; ++e) {
    const int t = sq * 8 + e;
    float z = ba;
#pragma unroll
    for (int rr = 0; rr < 16; ++rr) z += sGa[t * 16 + rr] * wu[rr];
    float la = (fminf(z, 0.f) - __logf(1.f + __expf(-fabsf(z)))) * (1.f / 16.f);
    if (t >= C) la = 0.f;
    run += la;
    bv[e] = run;
  }
  sSeg[sq * 64 + k] = run;
  __syncthreads();
  float off = 0.f, tot = 0.f;
#pragma unroll
  for (int s = 0; s < 8; ++s) {
    const float v = sSeg[s * 64 + k];
    if (s < sq) off += v;
    tot += v;
  }
#pragma unroll
  for (int e = 0; e < 8; ++e) bv[e] += off;
  blast = tot;
}

__device__ __forceinline__ void gla_load_vt(const Params& p, ushort_t* sVT, int kind, int b, int c, int h) {
  const int tid = ltid();
  const ushort_t* gvtp = (const ushort_t*)(p.ws + WS_GVTP);
  const ushort_t* gvts = (const ushort_t*)(p.ws + WS_GVTS);
#pragma unroll
  for (int i = 0; i < 2; ++i) {
    const int id = tid + 512 * i;
    const int row = id >> 3, c16 = id & 7;
    u32x4 v;
    if (kind == 0) v = *(const u32x4*)(gvtp + ((size_t)(b * 4 + h) * 128 + row) * 8192 + c * 64 + c16 * 8);
    else v = (c16 < 4) ? *(const u32x4*)(gvts + ((size_t)(b * 4 + h) * 128 + row) * 32 + c16 * 8) : (u32x4){0, 0, 0, 0};
    *(u32x4*)(sVT + row * GLD + c16 * 8) = v;
  }
}

__device__ __forceinline__ void gla_a_item(const Params& p, float* smemf, int kind, int b, int c, int h) {
  int tid_l = threadIdx.x; asm volatile("" : "+v"(tid_l));
  const int tid = tid_l, lane = tid & 63, w = tid >> 6;
  const int k = tid & 63, sq = tid >> 6;
  const int r = lane & 31, hh = lane >> 5;
  const int vs = w >> 1, ks = w & 1;
  const ushort_t* gqk = (const ushort_t*)(p.ws + WS_GQK);
  float* glat = (float*)(p.ws + WS_GLAT);
  float* glad = (float*)(p.ws + WS_GLAD);
  ushort_t* sKd = (ushort_t*)(smemf + GLA_PREP_FLOATS);
  ushort_t* sVT = sKd + 64 * GLD;
  float* sD = smemf + 2048 + 512;
  const int C = (kind == 0) ? 64 : 32;
  const int tok0 = (kind == 0) ? (b * 8192 + c * 64) : (TP + b * 32);
  float bv[8], blast;
  gla_prep(p, smemf, tok0, C, h, bv, blast);
  if (kind == 0) {
    float* bcum = (float*)(p.ws + WS_BCUM);
#pragma unroll
    for (int e = 0; e < 8; ++e) bcum[(size_t)(tok0 + sq * 8 + e) * 256 + h * 64 + k] = bv[e];
  }
  {
    unsigned pk[4];
#pragma unroll
    for (int e = 0; e < 8; e += 2) {
      const int t = sq * 8 + e;
      float a0 = 0.f, a1 = 0.f;
      if (t < C) {
        a0 = bf2f(gqk[(size_t)(tok0 + t) * 512 + 256 + h * 64 + k]) * __expf(blast - bv[e]);
        a1 = bf2f(gqk[(size_t)(tok0 + t + 1) * 512 + 256 + h * 64 + k]) * __expf(blast - bv[e + 1]);
      }
      pk[e >> 1] = pack2(a0, a1);
    }
    *(u32x4*)(sKd + k * GLD + sq * 8) = (u32x4){pk[0], pk[1], pk[2], pk[3]};
  }
  if (tid < 64) sD[tid] = __expf(blast);
  gla_load_vt(p, sVT, kind, b, c, h);
  __syncthreads();
  f32x16 acc;
#pragma unroll
  for (int i = 0; i < 16; ++i) acc[i] = 0.f;
#pragma unroll
  for (int s = 0; s < 4; ++s) {
    bf16x8 af = *(const bf16x8*)(sVT + (32 * vs + r) * GLD + 16 * s + 8 * hh);
    bf16x8 bfr = *(const bf16x8*)(sKd + (32 * ks + r) * GLD + 16 * s + 8 * hh);
    acc = MFMA32(af, bfr, acc);
  }
  if (kind == 0) {
    const int item = (b * 128 + c) * 4 + h;
    float* dst = glat + (size_t)item * 8192;
#pragma unroll
    for (int i = 0; i < 16; ++i) {
      const int v = 32 * vs + (i & 3) + 8 * (i >> 2) + 4 * hh;
      __builtin_nontemporal_store(acc[i], &dst[v * 64 + 32 * ks + r]);
    }
    if (tid < 64) glad[item * 64 + tid] = sD[tid];
  } else {
    const int kk = 32 * ks + r;
    const float d = sD[kk];
#pragma unroll
    for (int i4 = 0; i4 < 4; ++i4) {
      const int v0 = 32 * vs + 8 * i4 + 4 * hh;
      const size_t idx = ((size_t)(b * 4 + h) * 64 + kk) * 128 + v0;
      const f32x4 s0 = *(const f32x4*)(p.state_gla + idx);
      *(f32x4*)(p.out + O_GS + idx) = mkf4(d * s0.x + acc[4 * i4], d * s0.y + acc[4 * i4 + 1],
                                            d * s0.z + acc[4 * i4 + 2], d * s0.w + acc[4 * i4 + 3]);
    }
  }

}

__device__ __forceinline__ void p5_tile(const Params& p, LAS ushort_t* shm, int mt, int nt);
__device__ __forceinline__ void p6_tile(const Params& p, LAS ushort_t* shm, int mt, int nt);
__device__ __forceinline__ void phase3(const Params& p, LAS ushort_t* shm) {
  const float* glat = (const float*)(p.ws + WS_GLAT);
  const float* glad = (const float*)(p.ws + WS_GLAD);
  ushort_t* glas = (ushort_t*)(p.ws + WS_GLAS);
  const int tid = ltid();
  const int G = gridDim.x;
  const int nscan = (G >= 144) ? 128 : G;
  if ((int)blockIdx.x < nscan) {
    for (int e = blockIdx.x * NT + tid; e < 65536; e += nscan * NT) {
      const int bh = e >> 13, vk = e & 8191;
      const int b = bh >> 2, h = bh & 3;
      float S = 0.f;
      for (int c0 = 0; c0 < 128; c0 += 16) {
        float tv[16], dv[16];
#pragma unroll
        for (int u = 0; u < 16; ++u) {
          const int item = (b * 128 + c0 + u) * 4 + h;
          tv[u] = __builtin_nontemporal_load(&glat[(size_t)item * 8192 + vk]);
          dv[u] = glad[item * 64 + (vk & 63)];
        }
#pragma unroll
        for (int u = 0; u < 16; ++u) {
          const int item = (b * 128 + c0 + u) * 4 + h;
          glas[(size_t)item * 8192 + vk] = f2bf(S);
          S = dv[u] * S + tv[u];
        }
      }
      const int v = vk >> 6, k = vk & 63;
      p.out[O_GP + ((size_t)bh * 64 + k) * 128 + v] = S;
    }
  }
  {
    const int first = (G >= 144) ? 128 : 0, nb = (G >= 144) ? (G - 128) : G;
    const int me = (int)blockIdx.x - first;
    if (me >= 0) for (int i = me; i < 16; i += nb) p5_tile(p, shm, 64 + (i >> 2), i & 3);
  }
}

__device__ __forceinline__ void gla_c_item(const Params& p, float* smemf, int kind, int b, int c, int h) {
  int tid_l = threadIdx.x; asm volatile("" : "+v"(tid_l));
  const int tid = tid_l, lane = tid & 63, w = tid >> 6;
  const int k = tid & 63, sq = tid >> 6;
  const int r = lane & 31, hh = lane >> 5;
  const int tg = w & 1, vq = w >> 1;
  const ushort_t* gqk = (const ushort_t*)(p.ws + WS_GQK);
  const ushort_t* glas = (const ushort_t*)(p.ws + WS_GLAS);
  const ushort_t* ggs = (const ushort_t*)(p.ws + WS_GGS);
  ushort_t* obf = (ushort_t*)(p.ws + WS_OBF);
  ushort_t* sQ = (ushort_t*)(smemf + GLA_PREP_FLOATS);
  ushort_t* sKt = sQ + 64 * GLD;
  ushort_t* sVT = sKt + 64 * GLD;
  ushort_t* sST = sVT + 128 * GLD;
  float* sSsq = (float*)(sST + 128 * GLD);
  const int C = (kind == 0) ? 64 : 32;
  const int tok0 = (kind == 0) ? (b * 8192 + c * 64) : (TP + b * 32);
  u32x2 sg_e[4];
  f32x4 g_e[4];
  {
    const int tcol_e = 32 * tg + r;
    const int tok_e = tok0 + ((tcol_e < C) ? tcol_e : 0);
#pragma unroll
    for (int i4 = 0; i4 < 4; ++i4) {
      const int v0 = 32 * vq + 8 * i4 + 4 * hh;
      g_e[i4] = *(const f32x4*)(p.gla_norm_g + v0);
      sg_e[i4] = *(const u32x2*)(ggs + (size_t)tok_e * 512 + h * 128 + v0);
    }
  }
  float bv[8], blast;
  if (kind == 0) {
    const float* bcum = (const float*)(p.ws + WS_BCUM);
#pragma unroll
    for (int e = 0; e < 8; ++e) bv[e] = bcum[(size_t)(tok0 + sq * 8 + e) * 256 + h * 64 + k];
    blast = 0.f;
    __syncthreads();
  } else {
    gla_prep(p, smemf, tok0, C, h, bv, blast);
  }
#pragma unroll
  for (int e = 0; e < 8; ++e) {
    const int t = sq * 8 + e;
    float qv = 0.f, kv = 0.f;
    if (t < C) {
      qv = bf2f(gqk[(size_t)(tok0 + t) * 512 + h * 64 + k]) * __expf(bv[e]);
      kv = bf2f(gqk[(size_t)(tok0 + t) * 512 + 256 + h * 64 + k]) * __expf(-bv[e]);
    }
    sQ[t * GLD + k] = f2bf(qv);
    sKt[t * GLD + k] = f2bf(kv);
  }
  gla_load_vt(p, sVT, kind, b, c, h);
  if (kind == 0) {
    const int item = (b * 128 + c) * 4 + h;
#pragma unroll
    for (int i = 0; i < 2; ++i) {
      const int id = tid + 512 * i;
      const int row = id >> 3, c16 = id & 7;
      *(u32x4*)(sST + row * GLD + c16 * 8) = *(const u32x4*)(glas + (size_t)item * 8192 + row * 64 + c16 * 8);
    }
  } else {
#pragma unroll
    for (int i = 0; i < 4; ++i) {
      const int id = tid + 512 * i;
      const int kk = id >> 5, v0 = (id & 31) * 4;
      const f32x4 s0 = *(const f32x4*)(p.state_gla + ((size_t)(b * 4 + h) * 64 + kk) * 128 + v0);
      sST[(v0 + 0) * GLD + kk] = f2bf(s0.x);
      sST[(v0 + 1) * GLD + kk] = f2bf(s0.y);
      sST[(v0 + 2) * GLD + kk] = f2bf(s0.z);
      sST[(v0 + 3) * GLD + kk] = f2bf(s0.w);
    }
  }
  __syncthreads();
  bf16x8 qf[4];
#pragma unroll
  for (int s = 0; s < 4; ++s) qf[s] = *(const bf16x8*)(sQ + (32 * tg + r) * GLD + 16 * s + 8 * hh);
  f32x16 X0, X1;
#pragma unroll
  for (int i = 0; i < 16; ++i) { X0[i] = 0.f; X1[i] = 0.f; }
#pragma unroll
  for (int s = 0; s < 4; ++s) {
    bf16x8 kf = *(const bf16x8*)(sKt + r * GLD + 16 * s + 8 * hh);
    X0 = MFMA32(kf, qf[s], X0);
  }
  if (tg == 1) {
#pragma unroll
    for (int s = 0; s < 4; ++s) {
      bf16x8 kf = *(const bf16x8*)(sKt + (32 + r) * GLD + 16 * s + 8 * hh);
      X1 = MFMA32(kf, qf[s], X1);
    }
  }
  const int tcol = 32 * tg + r;
#pragma unroll
  for (int i = 0; i < 16; ++i) {
    const int srow = (i & 3) + 8 * (i >> 2) + 4 * hh;
    if (srow > tcol) X0[i] = 0.f;
    if (srow + 32 > tcol) X1[i] = 0.f;
  }
  f32x16 acc;
#pragma unroll
  for (int i = 0; i < 16; ++i) acc[i] = 0.f;
#pragma unroll
  for (int s = 0; s < 4; ++s) {
    bf16x8 af = *(const bf16x8*)(sST + (32 * vq + r) * GLD + 16 * s + 8 * hh);
    acc = MFMA32(af, qf[s], acc);
  }
#pragma unroll
  for (int s2 = 0; s2 < 2; ++s2) {
    union { bf16x8 v; unsigned u[4]; } pb;
#pragma unroll
    for (int j = 0; j < 4; ++j) pb.u[j] = pack2(X0[8 * s2 + 2 * j], X0[8 * s2 + 2 * j + 1]);
    union { bf16x8 v; u32x2 d[2]; } vf;
    const ushort_t* vp = sVT + (32 * vq + r) * GLD + 16 * s2 + 4 * hh;
    vf.d[0] = *(const u32x2*)vp;
    vf.d[1] = *(const u32x2*)(vp + 8);
    acc = MFMA32(vf.v, pb.v, acc);
  }
  if (tg == 1) {
#pragma unroll
    for (int s2 = 0; s2 < 2; ++s2) {
      union { bf16x8 v; unsigned u[4]; } pb;
#pragma unroll
      for (int j = 0; j < 4; ++j) pb.u[j] = pack2(X1[8 * s2 + 2 * j], X1[8 * s2 + 2 * j + 1]);
      union { bf16x8 v; u32x2 d[2]; } vf;
      const ushort_t* vp = sVT + (32 * vq + r) * GLD + 32 + 16 * s2 + 4 * hh;
      vf.d[0] = *(const u32x2*)vp;
      vf.d[1] = *(const u32x2*)(vp + 8);
      acc = MFMA32(vf.v, pb.v, acc);
    }
  }
  float ssq = 0.f;
#pragma unroll
  for (int i = 0; i < 16; ++i) ssq += acc[i] * acc[i];
  ssq += __shfl_xor(ssq, 32);
  if (hh == 0) sSsq[vq * 64 + tcol] = ssq;
  __syncthreads();
  const float tot = sSsq[tcol] + sSsq[64 + tcol] + sSsq[128 + tcol] + sSsq[192 + tcol];
  const float rn = rsqrtf(tot * (1.f / 128.f) + EPS);
  if (tcol < C) {
    const int tok = tok0 + tcol;
#pragma unroll
    for (int i4 = 0; i4 < 4; ++i4) {
      const int v0 = 32 * vq + 8 * i4 + 4 * hh;
      const f32x4 g = g_e[i4];
      const u32x2 sg = sg_e[i4];
      *(u32x2*)(obf + (size_t)tok * 512 + h * 128 + v0) =
          pack4(acc[4 * i4] * rn * g.x * bflo(sg.x), acc[4 * i4 + 1] * rn * g.y * bfhi(sg.x),
                acc[4 * i4 + 2] * rn * g.z * bflo(sg.y), acc[4 * i4 + 3] * rn * g.w * bfhi(sg.y));
    }
  }

}

__device__ __forceinline__ void p5_tile(const Params& p, LAS ushort_t* shm, int mt, int nt) {
  const ushort_t* oaf = (const ushort_t*)(p.ws + WS_OAF);
  const ushort_t* obf = (const ushort_t*)(p.ws + WS_OBF);
  const ushort_t* wat = (const ushort_t*)(p.ws + WS_WAT);
  const ushort_t* wbt = (const ushort_t*)(p.ws + WS_WBT);
  const ushort_t* mgs = (const ushort_t*)(p.ws + WS_MGS);
  ushort_t* mix = (ushort_t*)(p.ws + WS_MIX);
  const int n0 = nt * 256, t0 = mt * 256;
  f32x4 acc[2][2][4][2];
  gemm256(wat + (size_t)n0 * 512, oaf + (size_t)t0 * 512, 512, shm, acc);
  ACC_FOREACH({
    const int t = t0 + Cc; const int nn = n0 + R;
    const u32x2 g = __builtin_nontemporal_load((const u32x2*)(mgs + (size_t)t * 2048 + nn));
    v[0] *= bflo(g.x); v[1] *= bfhi(g.x); v[2] *= bflo(g.y); v[3] *= bfhi(g.y);
  })
  gemm256<false>(wbt + (size_t)n0 * 512, obf + (size_t)t0 * 512, 512, shm, acc);
  ACC_FOREACH_PAIR({
    const int nn = n0 + R;
    const u32x2 gb0 = __builtin_nontemporal_load((const u32x2*)(mgs + (size_t)(t0 + Cb) * 2048 + 1024 + nn));
    const u32x2 gb1 = __builtin_nontemporal_load((const u32x2*)(mgs + (size_t)(t0 + Cb + 16) * 2048 + 1024 + nn));
    const u32x2 p0 = pack4(v0[0] * bflo(gb0.x), v0[1] * bfhi(gb0.x), v0[2] * bflo(gb0.y), v0[3] * bfhi(gb0.y));
    const u32x2 p1 = pack4(v1[0] * bflo(gb1.x), v1[1] * bfhi(gb1.x), v1[2] * bflo(gb1.y), v1[3] * bfhi(gb1.y));
    *(u32x4*)(mix + (size_t)(t0 + Tw) * 1024 + n0 + Rw) = widen16(p0, p1);
  })
}

__device__ __forceinline__ void p6_tile(const Params& p, LAS ushort_t* shm, int mt, int nt) {
  const ushort_t* mix = (const ushort_t*)(p.ws + WS_MIX);
  const ushort_t* wot = (const ushort_t*)(p.ws + WS_WOT);
  const int n0 = nt * 256, t0 = mt * 256;
  f32x4 acc[2][2][4][2];
  gemm256(wot + (size_t)n0 * 1024, mix + (size_t)t0 * 1024, 1024, shm, acc);
  ACC_FOREACH({
    const int t = t0 + Cc; const int nn = n0 + R;
    *(f32x4*)(p.out + (size_t)t * DM + nn) = v;
  })
}

__device__ __forceinline__ void phase5(const Params& p, LAS ushort_t* shm) {
  for (int it = blockIdx.x; it < 256; it += gridDim.x) {
    int nt, mt; tile_map(it, 64, 4, mt, nt);
    p5_tile(p, shm, mt, nt);
  }
}
__device__ __forceinline__ void phase6(const Params& p, LAS ushort_t* shm) {
  for (int it = blockIdx.x; it < 256; it += gridDim.x) {
    int nt, mt; tile_map(it, 64, 4, mt, nt);
    p6_tile(p, shm, mt, nt);
  }
}

__device__ __forceinline__ void phase7(const Params& p) {
  const int tid = ltid(), wave = tid >> 6, lane = tid & 63;
  for (int row = blockIdx.x * 8 + wave; row < TT; row += gridDim.x * 8) {
    float* yr = (row < TP) ? (p.out + O_YP + (size_t)row * DM) : (p.out + O_YS + (size_t)(row - TP) * DM);
    const float* xr = (row < TP) ? (p.x_prompt + (size_t)row * DM) : (p.x_sample + (size_t)(row - TP) * DM);
    f32x4 v[4];
    float ss = 0.f;
#pragma unroll
    for (int i = 0; i < 4; ++i) {
      const f32x4 a = __builtin_nontemporal_load(&((const f32x4*)yr)[lane + 64 * i]);
      const f32x4 x = __builtin_nontemporal_load(&((const f32x4*)xr)[lane + 64 * i]);
      v[i] = mkf4(a.x + x.x, a.y + x.y, a.z + x.z, a.w + x.w);
      ss += v[i].x * v[i].x + v[i].y * v[i].y + v[i].z * v[i].z + v[i].w * v[i].w;
    }
    ss = wave_sum(ss);
    const float rn = rsqrtf(ss * (1.f / DM) + EPS);
#pragma unroll
    for (int i = 0; i < 4; ++i) {
      const f32x4 g = ((const f32x4*)p.norm_final_g)[lane + 64 * i];
      __builtin_nontemporal_store(mkf4(v[i].x * rn * g.x, v[i].y * rn * g.y, v[i].z * rn * g.z, v[i].w * rn * g.w), &((f32x4*)yr)[lane + 64 * i]);
    }
  }
}

#define SMEM_BYTES (4 * ABUF * 2)

template <int PH>
__device__ __forceinline__ void run_phase(const Params& p, unsigned char* smem_raw, int* s_item_p, float lam, int rep = 0) {
  const int tid = ltid();
  ushort_t* smem = (ushort_t*)smem_raw;
  float* smemf = (float*)smem_raw;
  LAS ushort_t* shm = (LAS ushort_t*)smem_raw;
  if (!PH_ON(PH)) return;
  if (PH == 0) {
    phase0(p, smemf);
  } else if (PH == 1) {
    phase1(p, shm);
  } else if (PH == 2) {
    unsigned* qbase = (unsigned*)(p.ws + WS_CTRL) + 8192;
    int q = (int)(xb_xcc_id() & 7u);
    for (;;) {
      __syncthreads();
      if (tid == 0) *s_item_p = (int)atomicAdd(qbase + 64 * q, 1u);
      __syncthreads();
      const int it = *s_item_p;
      if (it >= 240) {
        __syncthreads();
        if (tid == 0) {
          unsigned hv[8];
#pragma unroll
          for (int j = 0; j < 8; ++j) hv[j] = xb_ld(qbase + 64 * ((q + 1 + j) & 7));
          int nq = -1;
#pragma unroll
          for (int j = 7; j >= 0; --j) if (hv[j] < 240u) nq = (q + 1 + j) & 7;
          *s_item_p = nq;
        }
        __syncthreads();
        const int nq = *s_item_p;
        if (nq < 0) break;
        q = nq;
        continue;
      }
      if (it >= 46 && it < 62) {
        const int idx = q * 16 + (it - 46);
        attn_item(p, smem, 1, idx >> 2, idx & 3, 0, lam);
      } else if (it < 80) {
        const int qp = 63 - ((it < 46) ? it : (it - 16));
        attn_item(p, smem, 0, q >> 2, q & 3, qp, lam);
      } else if (it >= 224) {
        const int j = q * 16 + (it - 224);
        gla_c_item(p, smemf, 1, j >> 2, 0, j & 3);
      } else {
        const int g = q * 144 + (it - 80);
        if (g < 1024) {
#if P2SUB & 4
          gla_a_item(p, smemf, 0, g >> 9, (g >> 2) & 127, g & 3);
#endif
        } else {
          const int j = g - 1024;
#if P2SUB & 8
          gla_a_item(p, smemf, 1, j >> 2, 0, j & 3);
#endif
        }
      }
    }
  } else if (PH == 3) {
    phase3(p, shm);
  } else if (PH == 4) {
    const int G = gridDim.x;
    const int ngc = (G >= 32) ? (G - 16) : G;
    if ((int)blockIdx.x < ngc) {
      for (int it = blockIdx.x; it < 1024; it += ngc) gla_c_item(p, smemf, 0, it >> 9, (it >> 2) & 127, it & 3);
    }
    {
      const int first = (G >= 32) ? (G - 16) : 0, nb = (G >= 32) ? 16 : G;
      const int me = (int)blockIdx.x - first;
      if (me >= 0) for (int i = me; i < 16; i += nb) p6_tile(p, shm, 64 + (i >> 2), i & 3);
    }
  } else if (PH == 5) {
    phase5(p, shm);
  } else if (PH == 6) {
    phase6(p, shm);
  } else {
    phase7(p);
  }
}

__global__ void __launch_bounds__(NT, 2) fwd_kernel(Params p) {
  __shared__ __attribute__((aligned(16))) unsigned char smem_raw[SMEM_BYTES + 32];
  int* s_item = (int*)(smem_raw + SMEM_BYTES + 16);
  volatile unsigned* xb_words = (volatile unsigned*)(smem_raw + SMEM_BYTES);
  const int tid = ltid();

  const float lam = 0.f;
#if MK_ONE_LAUNCH
  if (tid == 0) { xb_words[0] = 0u; xb_words[1] = 0u; }
  __syncthreads();
  XcdBarrier xb = xcd_barrier_post((unsigned*)(p.ws + WS_CTRL), xb_words);
  for (int rep = 0; rep < (REP_ON(0) ? 2 : 1); ++rep) { run_phase<0>(p, smem_raw, s_item, lam, rep); xcd_barrier(xb); }
  for (int rep = 0; rep < (REP_ON(1) ? 2 : 1); ++rep) { run_phase<1>(p, smem_raw, s_item, lam, rep); xcd_barrier(xb); }
  for (int rep = 0; rep < (REP_ON(2) ? 2 : 1); ++rep) { run_phase<2>(p, smem_raw, s_item, lam, rep); xcd_barrier(xb); }
  for (int rep = 0; rep < (REP_ON(3) ? 2 : 1); ++rep) { run_phase<3>(p, smem_raw, s_item, lam, rep); xcd_barrier(xb); }
  for (int rep = 0; rep < (REP_ON(4) ? 2 : 1); ++rep) { run_phase<4>(p, smem_raw, s_item, lam, rep); xcd_barrier(xb); }
  for (int rep = 0; rep < (REP_ON(5) ? 2 : 1); ++rep) { run_phase<5>(p, smem_raw, s_item, lam, rep); xcd_barrier(xb); }
  for (int rep = 0; rep < (REP_ON(6) ? 2 : 1); ++rep) { run_phase<6>(p, smem_raw, s_item, lam, rep); xcd_barrier(xb); }
  run_phase<7>(p, smem_raw, s_item, lam);
#else
  switch (p.phase_lo) {
    case 0: run_phase<0>(p, smem_raw, s_item, lam); break;
    case 1: run_phase<1>(p, smem_raw, s_item, lam); break;
    case 2: run_phase<2>(p, smem_raw, s_item, lam); break;
    case 3: run_phase<3>(p, smem_raw, s_item, lam); break;
    case 4: run_phase<4>(p, smem_raw, s_item, lam); break;
    case 5: run_phase<5>(p, smem_raw, s_item, lam); break;
    case 6: run_phase<6>(p, smem_raw, s_item, lam); break;
    default: run_phase<7>(p, smem_raw, s_item, lam); break;
  }
#endif
}

extern "C" void kernel_launch(void* const* d_in, const int* in_sizes, int n_in, void* d_out, int out_size, void* d_ws,
                              size_t ws_size, hipStream_t stream) {
  static int grid_blocks = 0;
  if (!grid_blocks) {
    int dev = 0, cus = 0;
    (void)hipGetDevice(&dev);
    (void)hipDeviceGetAttribute(&cus, hipDeviceAttributeMultiprocessorCount, dev);
    if (cus <= 0) cus = 256;
    grid_blocks = cus;
  }
  Params p{};
  p.x_prompt = (const float*)d_in[0]; p.x_sample = (const float*)d_in[1]; p.cache_k = (const float*)d_in[2];
  p.cache_v = (const float*)d_in[3]; p.state_gla = (const float*)d_in[4]; p.norm_in_g = (const float*)d_in[5];
  p.w_in = (const float*)d_in[6]; p.w_alpha_up = (const float*)d_in[7]; p.b_alpha = (const float*)d_in[8];
  p.lq1 = (const float*)d_in[9]; p.lk1 = (const float*)d_in[10]; p.lq2 = (const float*)d_in[11]; p.lk2 = (const float*)d_in[12];
  p.da_norm_g = (const float*)d_in[13]; p.gla_norm_g = (const float*)d_in[14]; p.w_branch_a = (const float*)d_in[15];
  p.w_branch_b = (const float*)d_in[16]; p.w_out = (const float*)d_in[17]; p.norm_final_g = (const float*)d_in[18];
  p.out = (float*)d_out; p.ws = (char*)d_ws;
  (void)hipMemsetAsync(d_ws, 0, 65536, stream);
#if MK_ONE_LAUNCH
  p.phase_lo = 0; p.phase_hi = 7;
  void* args[] = {&p};
  hipError_t e = hipLaunchCooperativeKernel((void*)fwd_kernel, dim3(grid_blocks), dim3(NT), args, 0, stream);
  if (e != hipSuccess) fprintf(stderr, "cooperative launch failed: %s (grid %d)\n", hipGetErrorString(e), grid_blocks);
#else
  for (int ph = 0; ph <= 7; ++ph) {
    p.phase_lo = ph; p.phase_hi = ph;
    fwd_kernel<<<dim3(grid_blocks), dim3(NT), 0, stream>>>(p);
  }
#endif
}
```
